# Optimizing an MI355X kernel written in HIP

```python
import math
import jax, jax.numpy as jnp
from jax import lax
import numpy as np

D_MODEL = 1024
BATCH = 16
SEQ = 2048
DEPTH = 1

HEAD_DIM = 64
ATTN_WIDTH = D_MODEL // 2
ATTN_HEADS = ATTN_WIDTH // HEAD_DIM
SSM_WIDTH = D_MODEL - ATTN_WIDTH
SSM_GROUP = 16
SSM_GROUPS = SSM_WIDTH // SSM_GROUP
SSM_STATE = 64
MIX_WIDTH = ATTN_WIDTH + SSM_WIDTH
IN_COLS = 3 * ATTN_WIDTH + ATTN_HEADS + SSM_WIDTH
Q_BLOCK = 128
N_EXPERT_GROUPS = 4
EXPERTS_PER_GROUP = 8
N_EXPERTS = N_EXPERT_GROUPS * EXPERTS_PER_GROUP
TOP_K_IN_GROUP = 2
D_EXPERT = D_MODEL // 2
MOE_BLOCK = 256
DEEPNORM_ALPHA = (2.0 * DEPTH) ** 0.25
DEEPNORM_BETA = (8.0 * DEPTH) ** -0.25
LN_EPS = 1e-5
RMS_EPS = 1e-6

kernel_name = 'fox_s5_hymba_hmoe_deepnorm'


def layer_norm(x, g, b):
    xf = x.astype(jnp.float32)
    mu = jnp.mean(xf, axis=-1, keepdims=True)
    var = jnp.mean(jnp.square(xf - mu), axis=-1, keepdims=True)
    return ((xf - mu) * lax.rsqrt(var + LN_EPS) * g.astype(jnp.float32) + b.astype(jnp.float32)).astype(x.dtype)


def rms_norm(x, g, out_dtype):
    xf = x.astype(jnp.float32)
    y = xf * lax.rsqrt(jnp.mean(jnp.square(xf), axis=-1, keepdims=True) + RMS_EPS)
    return (y * g.astype(jnp.float32)).astype(out_dtype)


def forgetting_attention(q, k, v, log_f):
    seq = q.shape[2]
    scale = HEAD_DIM ** -0.5
    cum = jnp.cumsum(log_f, axis=-1)
    outs = []
    for blk in range(seq // Q_BLOCK):
        s0, s1 = blk * Q_BLOCK, (blk + 1) * Q_BLOCK
        qb, kb, vb = q[:, :, s0:s1], k[:, :, :s1], v[:, :, :s1]
        scores = jnp.einsum('bhqd,bhkd->bhqk', qb, kb).astype(jnp.float32) * scale
        scores = scores + (cum[:, :, s0:s1, None] - cum[:, :, None, :s1])
        mask = (s0 + jnp.arange(Q_BLOCK))[:, None] >= jnp.arange(s1)[None, :]
        scores = jnp.where(mask, scores, -jnp.inf)
        p = jax.nn.softmax(scores, axis=-1)
        outs.append(jnp.einsum('bhqk,bhkd->bhqd', p.astype(vb.dtype), vb))
    return jnp.concatenate(outs, axis=2)


def _complex_affine_combine(e1, e2):
    a1r, a1i, b1r, b1i = e1
    a2r, a2i, b2r, b2i = e2
    ar = a2r * a1r - a2i * a1i
    ai = a2r * a1i + a2i * a1r
    br = a2r * b1r - a2i * b1i + b2r
    bi = a2r * b1i + a2i * b1r + b2i
    return ar, ai, br, bi


def s5_branch(u, lam_re, lam_im, log_step, b_re, b_im, c_re, c_im, d_skip, w_glu, b_glu):
    f32 = jnp.float32
    bsz, seq, _ = u.shape
    u = u.astype(f32).reshape(bsz, seq, SSM_GROUPS, SSM_GROUP)
    lam_re, lam_im = lam_re.astype(f32), lam_im.astype(f32)
    delta = jnp.exp(log_step.astype(f32))[:, None]
    mag = jnp.exp(lam_re * delta)
    ar = mag * jnp.cos(lam_im * delta)
    ai = mag * jnp.sin(lam_im * delta)
    den = lam_re * lam_re + lam_im * lam_im
    num_re = ar - 1.0
    coef_re = (num_re * lam_re + ai * lam_im) / den
    coef_im = (ai * lam_re - num_re * lam_im) / den
    br, bi = b_re.astype(f32), b_im.astype(f32)
    bbar_re = coef_re[..., None] * br - coef_im[..., None] * bi
    bbar_im = coef_re[..., None] * bi + coef_im[..., None] * br
    bu_re = jnp.einsum('blgh,gph->blgp', u, bbar_re)
    bu_im = jnp.einsum('blgh,gph->blgp', u, bbar_im)
    a_re = jnp.broadcast_to(ar, bu_re.shape)
    a_im = jnp.broadcast_to(ai, bu_re.shape)
    _, _, xr, xi = lax.associative_scan(_complex_affine_combine, (a_re, a_im, bu_re, bu_im), axis=1)
    y = (jnp.einsum('blgp,ghp->blgh', xr, c_re.astype(f32))
         - jnp.einsum('blgp,ghp->blgh', xi, c_im.astype(f32))
         + d_skip.astype(f32) * u)
    y = jax.nn.gelu(y.reshape(bsz, seq, SSM_WIDTH))
    return y * jax.nn.sigmoid(y @ w_glu.astype(f32) + b_glu.astype(f32))


def hybrid_mixer(x, w_in, b_fgate, lam_re, lam_im, log_step, b_re, b_im, c_re, c_im, d_skip,
                 w_glu, b_glu, attn_norm_g, ssm_norm_g, w_out):
    bsz, seq, _ = x.shape
    z = jnp.einsum('bld,dc->blc', x, w_in)
    a = ATTN_WIDTH
    def heads(t):
        return t.reshape(bsz, seq, ATTN_HEADS, HEAD_DIM).transpose(0, 2, 1, 3)
    q, k, v = heads(z[..., :a]), heads(z[..., a:2 * a]), heads(z[..., 2 * a:3 * a])
    f_logit = z[..., 3 * a:3 * a + ATTN_HEADS].astype(jnp.float32) + b_fgate.astype(jnp.float32)
    log_f = jax.nn.log_sigmoid(f_logit).transpose(0, 2, 1)
    u = z[..., 3 * a + ATTN_HEADS:]
    attn = forgetting_attention(q, k, v, log_f).transpose(0, 2, 1, 3).reshape(bsz, seq, ATTN_WIDTH)
    ssm = s5_branch(u, lam_re, lam_im, log_step, b_re, b_im, c_re, c_im, d_skip, w_glu, b_glu)
    y = jnp.concatenate([rms_norm(attn, attn_norm_g, x.dtype), rms_norm(ssm, ssm_norm_g, x.dtype)], axis=-1)
    return jnp.einsum('blc,cd->bld', y, w_out)


def hierarchical_moe(h, w_rg, b_rg, w_re, b_re, w_gate, w_up, w_down):
    bsz, seq, d = h.shape
    n_tok = bsz * seq
    ht = h.reshape(n_tok, d)
    g_prob = jax.nn.softmax((ht @ w_rg + b_rg).astype(jnp.float32), axis=-1)
    g_p, g_idx = lax.top_k(g_prob, 1)
    e_logits = (ht @ w_re + b_re).astype(jnp.float32).reshape(n_tok, N_EXPERT_GROUPS, EXPERTS_PER_GROUP)
    e_in = jnp.take_along_axis(e_logits, g_idx[:, :, None], axis=1)[:, 0]
    e_p, e_loc = lax.top_k(jax.nn.softmax(e_in, axis=-1), TOP_K_IN_GROUP)
    e_p = e_p / jnp.sum(e_p, axis=-1, keepdims=True)
    gates = (g_p * e_p).reshape(-1)
    eid = (g_idx * EXPERTS_PER_GROUP + e_loc).reshape(-1).astype(jnp.int32)
    tok = jnp.repeat(jnp.arange(n_tok, dtype=jnp.int32), TOP_K_IN_GROUP)
    n_asg = n_tok * TOP_K_IN_GROUP
    order = jnp.argsort(eid)
    eid_s, tok_s, gate_s = eid[order], tok[order], gates[order]
    counts = jnp.bincount(eid, length=N_EXPERTS).astype(jnp.int32)
    starts = jnp.cumsum(counts) - counts
    padded = ((counts + MOE_BLOCK - 1) // MOE_BLOCK) * MOE_BLOCK
    pends = jnp.cumsum(padded)
    pstarts = pends - padded
    slot = pstarts[eid_s] + (jnp.arange(n_asg, dtype=jnp.int32) - starts[eid_s])
    n_pad = ((n_asg + N_EXPERTS * (MOE_BLOCK - 1) + MOE_BLOCK - 1) // MOE_BLOCK) * MOE_BLOCK
    n_blocks = n_pad // MOE_BLOCK
    slot_tok = jnp.full((n_pad,), n_tok, jnp.int32).at[slot].set(tok_s)
    x_pad = jnp.concatenate([ht, jnp.zeros((1, d), ht.dtype)], axis=0)
    xb = x_pad[slot_tok].reshape(n_blocks, MOE_BLOCK, d)
    block_e = jnp.minimum(jnp.searchsorted(pends, jnp.arange(n_blocks, dtype=jnp.int32) * MOE_BLOCK, side='right'),
                          N_EXPERTS - 1).astype(jnp.int32)

    def expert_block(args):
        xblk, e = args
        hid = jax.nn.silu(xblk @ w_gate[e]) * (xblk @ w_up[e])
        return hid @ w_down[e]

    yb = lax.map(expert_block, (xb, block_e)).reshape(n_pad, d)
    y_asg = yb[slot] * gate_s[:, None].astype(yb.dtype)
    y = jax.ops.segment_sum(y_asg, tok_s, num_segments=n_tok)
    return y.reshape(bsz, seq, d).astype(h.dtype)


def setup_inputs(seed: int = 0) -> dict:
    key = jax.random.key(seed)
    ks = jax.random.split(key, 32)
    f32 = jnp.float32
    L, G, P, H = DEPTH, SSM_GROUPS, SSM_STATE, SSM_GROUP

    def nrm(k, shape, scale):
        return jax.random.normal(k, shape, f32) * scale

    x = nrm(ks[0], (BATCH, SEQ, D_MODEL), 1.0)
    w_in = nrm(ks[1], (L, D_MODEL, IN_COLS), D_MODEL ** -0.5)
    b_fgate = jnp.linspace(1.0, 5.0, ATTN_HEADS, dtype=f32)[None, :] + nrm(ks[2], (L, ATTN_HEADS), 0.1)
    s5_lambda_re = -0.5 + nrm(ks[3], (L, G, P), 0.01)
    s5_lambda_im = math.pi * jnp.arange(P, dtype=f32) + nrm(ks[4], (L, G, P), 0.01)
    s5_log_step = jax.random.uniform(ks[5], (L, G), f32, math.log(1e-3), math.log(1e-1))
    s5_b_re = nrm(ks[6], (L, G, P, H), (2.0 * H) ** -0.5)
    s5_b_im = nrm(ks[7], (L, G, P, H), (2.0 * H) ** -0.5)
    s5_c_re = nrm(ks[8], (L, G, H, P), (2.0 * P) ** -0.5)
    s5_c_im = nrm(ks[9], (L, G, H, P), (2.0 * P) ** -0.5)
    s5_d = nrm(ks[10], (L, G, H), 1.0)
    w_glu = nrm(ks[11], (L, SSM_WIDTH, SSM_WIDTH), SSM_WIDTH ** -0.5)
    b_glu = nrm(ks[12], (L, SSM_WIDTH), 0.01)
    attn_norm_g = 1.0 + nrm(ks[13], (L, ATTN_WIDTH), 0.02)
    ssm_norm_g = 1.0 + nrm(ks[14], (L, SSM_WIDTH), 0.02)
    w_out = nrm(ks[15], (L, MIX_WIDTH, D_MODEL), MIX_WIDTH ** -0.5 * DEEPNORM_BETA)
    ln1_g = 1.0 + nrm(ks[16], (L, D_MODEL), 0.02)
    ln1_b = nrm(ks[17], (L, D_MODEL), 0.02)
    w_router_group = nrm(ks[18], (L, D_MODEL, N_EXPERT_GROUPS), D_MODEL ** -0.5)
    b_router_group = nrm(ks[19], (L, N_EXPERT_GROUPS), 0.01)
    w_router_expert = nrm(ks[20], (L, D_MODEL, N_EXPERTS), D_MODEL ** -0.5)
    b_router_expert = nrm(ks[21], (L, N_EXPERTS), 0.01)
    w_gate = nrm(ks[22], (L, N_EXPERTS, D_MODEL, D_EXPERT), D_MODEL ** -0.5)
    w_up = nrm(ks[23], (L, N_EXPERTS, D_MODEL, D_EXPERT), D_MODEL ** -0.5)
    w_down = nrm(ks[24], (L, N_EXPERTS, D_EXPERT, D_MODEL), D_EXPERT ** -0.5 * DEEPNORM_BETA)
    ln2_g = 1.0 + nrm(ks[25], (L, D_MODEL), 0.02)
    ln2_b = nrm(ks[26], (L, D_MODEL), 0.02)
    return {'x': x, 'w_in': w_in, 'b_fgate': b_fgate,
            's5_lambda_re': s5_lambda_re, 's5_lambda_im': s5_lambda_im, 's5_log_step': s5_log_step,
            's5_b_re': s5_b_re, 's5_b_im': s5_b_im, 's5_c_re': s5_c_re, 's5_c_im': s5_c_im, 's5_d': s5_d,
            'w_glu': w_glu, 'b_glu': b_glu, 'attn_norm_g': attn_norm_g, 'ssm_norm_g': ssm_norm_g,
            'w_out': w_out, 'ln1_g': ln1_g, 'ln1_b': ln1_b,
            'w_router_group': w_router_group, 'b_router_group': b_router_group,
            'w_router_expert': w_router_expert, 'b_router_expert': b_router_expert,
            'w_gate': w_gate, 'w_up': w_up, 'w_down': w_down, 'ln2_g': ln2_g, 'ln2_b': ln2_b}


def reference(x, w_in, b_fgate, s5_lambda_re, s5_lambda_im, s5_log_step, s5_b_re, s5_b_im,
              s5_c_re, s5_c_im, s5_d, w_glu, b_glu, attn_norm_g, ssm_norm_g, w_out, ln1_g, ln1_b,
              w_router_group, b_router_group, w_router_expert, b_router_expert,
              w_gate, w_up, w_down, ln2_g, ln2_b):
    for l in range(DEPTH):
        mix = hybrid_mixer(x, w_in[l], b_fgate[l], s5_lambda_re[l], s5_lambda_im[l], s5_log_step[l],
                           s5_b_re[l], s5_b_im[l], s5_c_re[l], s5_c_im[l], s5_d[l], w_glu[l], b_glu[l],
                           attn_norm_g[l], ssm_norm_g[l], w_out[l])
        x = layer_norm(DEEPNORM_ALPHA * x + mix, ln1_g[l], ln1_b[l])
        moe = hierarchical_moe(x, w_router_group[l], b_router_group[l], w_router_expert[l],
                               b_router_expert[l], w_gate[l], w_up[l], w_down[l])
        x = layer_norm(DEEPNORM_ALPHA * x + moe, ln2_g[l], ln2_b[l])
    return x
```

```cpp
#include <hip/hip_runtime.h>
#include <cstdint>
#include <cstdio>

#define LAS __attribute__((address_space(3)))
typedef unsigned short bf16_t;
typedef short bf16x8 __attribute__((ext_vector_type(8)));
typedef float f32x4 __attribute__((ext_vector_type(4)));
typedef float f32x16 __attribute__((ext_vector_type(16)));
typedef unsigned u32x4 __attribute__((ext_vector_type(4)));
typedef unsigned u32x2 __attribute__((ext_vector_type(2)));

constexpr int BATCH = 16, SEQ = 2048, T = BATCH * SEQ, DM = 1024;
constexpr int AW = 512, NH = 8, HD = 64, SWD = 512, SGC = 16, NG = 32, SP = 64, INC = 2056;
constexpr int NE = 32, DE = 512;
constexpr int TC = 16, NCH = SEQ / TC, UXK = 384;
constexpr float ALPHA = 1.189207115002721f;
constexpr float LN_EPS = 1e-5f, RMS_EPS = 1e-6f;
constexpr float LOG2E = 1.4426950408889634f;
constexpr float C2 = 0.125f * LOG2E;

constexpr size_t MiB = 1u << 20;
constexpr size_t WS_CTL = 0, CTL_BYTES = 1 * MiB;
constexpr size_t WS_WIN = 2 * MiB;
constexpr size_t WS_WGLU = 6 * MiB;
constexpr size_t WS_WOUT = 7 * MiB;
constexpr size_t WS_S5S = 9 * MiB;
constexpr size_t WS_S5W = 11 * MiB;
constexpr size_t WS_S5A = 17 * MiB;
constexpr size_t WS_WGU = 18 * MiB;
constexpr size_t WS_WD = 82 * MiB;
constexpr size_t WS_XB = 114 * MiB;
constexpr size_t WS_HID = WS_XB;
constexpr size_t WS_Q = 179 * MiB, WS_K = 211 * MiB, WS_V = 243 * MiB;
constexpr size_t WS_UX = 275 * MiB;
constexpr size_t WS_YASG = 179 * MiB;
constexpr size_t WS_YCAT = 323 * MiB;
constexpr size_t WS_Y = 387 * MiB;
constexpr size_t WS_HB = 419 * MiB;
constexpr size_t WS_SLOC = WS_HB;
constexpr size_t WS_CUM = 483 * MiB;
constexpr size_t WS_LOGF = 484 * MiB;
constexpr size_t WS_GATE = 485 * MiB;
constexpr size_t WS_LIST = 486 * MiB;
constexpr size_t WS_END = 512 * MiB;
constexpr int CW_CNT = 1024;

struct Args { const float* in[27]; float* out; unsigned char* ws; int ph_lo, ph_hi; };

struct Ctx {
    int tid, lane, wave, wgid, G, gw, NGW;
    LAS unsigned char* lds;
    const Args* a;
#define CIN(name, idx) __device__ __forceinline__ const float* name() const { return a->in[idx]; }
    CIN(x_, 0) CIN(w_in_, 1) CIN(b_fgate_, 2) CIN(lam_re_, 3) CIN(lam_im_, 4) CIN(log_step_, 5) CIN(b_re_, 6) CIN(b_im_, 7) CIN(c_re_, 8) CIN(c_im_, 9) CIN(dskip_, 10)
    CIN(w_glu_, 11) CIN(b_glu_, 12) CIN(attn_g_, 13) CIN(ssm_g_, 14) CIN(w_out_, 15) CIN(ln1_g_, 16) CIN(ln1_b_, 17) CIN(w_rg_, 18) CIN(b_rg_, 19) CIN(w_re_, 20) CIN(b_re2_, 21)
    CIN(w_gate_, 22) CIN(w_up_, 23) CIN(w_down_, 24) CIN(ln2_g_, 25) CIN(ln2_b_, 26)
#undef CIN
#define CWS(type, name, off) __device__ __forceinline__ type* name() const { return (type*)(a->ws + (off)); }
    CWS(unsigned, ctl_, WS_CTL) CWS(bf16_t, Win_, WS_WIN) CWS(bf16_t, Wglu_, WS_WGLU) CWS(bf16_t, Wout_, WS_WOUT) CWS(bf16_t, S5S_, WS_S5S) CWS(bf16_t, S5W_, WS_S5W)
    CWS(bf16_t, Wgu_, WS_WGU) CWS(bf16_t, Wd_, WS_WD) CWS(bf16_t, XB_, WS_XB) CWS(bf16_t, HID_, WS_HID) CWS(bf16_t, Q_, WS_Q) CWS(bf16_t, K_, WS_K) CWS(bf16_t, V_, WS_V)
    CWS(bf16_t, UX_, WS_UX) CWS(bf16_t, YASG_, WS_YASG) CWS(bf16_t, YCAT_, WS_YCAT) CWS(bf16_t, Y_, WS_Y) CWS(bf16_t, HB_, WS_HB)
    CWS(float, S5A_, WS_S5A) CWS(float, SLOC_, WS_SLOC) CWS(float, CUM_, WS_CUM) CWS(float, LOGF_, WS_LOGF) CWS(float, GATE_, WS_GATE) CWS(int, LIST_, WS_LIST)
#undef CWS
    __device__ __forceinline__ float* out_() const { return a->out; }
};

__device__ __forceinline__ unsigned f2bf(float f) { unsigned u = __builtin_bit_cast(unsigned, f); return (u + 0x7fffu + ((u >> 16) & 1u)) >> 16; }
__device__ __forceinline__ float bf2f(unsigned short b) { return __builtin_bit_cast(float, (unsigned)b << 16); }
__device__ __forceinline__ unsigned pk2(float lo, float hi) { return f2bf(lo) | (f2bf(hi) << 16); }
__device__ __forceinline__ float wave_sum(float v) {
#pragma unroll
    for (int o = 1; o < 64; o <<= 1) v += __shfl_xor(v, o);
    return v;
}
__device__ __forceinline__ int crow(int r, int hi) { return (r & 3) + 8 * (r >> 2) + 4 * hi; }
__device__ __forceinline__ float sigmoidf_(float s) { return 1.0f / (1.0f + __expf(-s)); }
__device__ __forceinline__ float gelu_tanh(float v) { const float z = 0.7978845608028654f * (v + 0.044715f * v * v * v); const float t = 1.0f - 2.0f / (__expf(2.0f * z) + 1.0f); return 0.5f * v * (1.0f + t); }

__device__ __forceinline__ void wave_gemm64(const bf16_t* a0, const bf16_t* a1, const bf16_t* b0, const bf16_t* b1, int K,
                                            f32x16& c00, f32x16& c01, f32x16& c10, f32x16& c11) {
    c00 = (f32x16){}; c01 = (f32x16){}; c10 = (f32x16){}; c11 = (f32x16){};
    for (int k = 0; k < K; k += 32) {
        const bf16x8 A0 = *(const bf16x8*)(a0 + k), A1 = *(const bf16x8*)(a1 + k), B0 = *(const bf16x8*)(b0 + k), B1 = *(const bf16x8*)(b1 + k);
        const bf16x8 A0b = *(const bf16x8*)(a0 + k + 16), A1b = *(const bf16x8*)(a1 + k + 16), B0b = *(const bf16x8*)(b0 + k + 16), B1b = *(const bf16x8*)(b1 + k + 16);
        c00 = __builtin_amdgcn_mfma_f32_32x32x16_bf16(A0, B0, c00, 0, 0, 0);
        c01 = __builtin_amdgcn_mfma_f32_32x32x16_bf16(A0, B1, c01, 0, 0, 0);
        c10 = __builtin_amdgcn_mfma_f32_32x32x16_bf16(A1, B0, c10, 0, 0, 0);
        c11 = __builtin_amdgcn_mfma_f32_32x32x16_bf16(A1, B1, c11, 0, 0, 0);
        c00 = __builtin_amdgcn_mfma_f32_32x32x16_bf16(A0b, B0b, c00, 0, 0, 0);
        c01 = __builtin_amdgcn_mfma_f32_32x32x16_bf16(A0b, B1b, c01, 0, 0, 0);
        c10 = __builtin_amdgcn_mfma_f32_32x32x16_bf16(A1b, B0b, c10, 0, 0, 0);
        c11 = __builtin_amdgcn_mfma_f32_32x32x16_bf16(A1b, B1b, c11, 0, 0, 0);
    }
}
#define FOR_ACC(c00, c01, c10, c11, ...) do { const int hi_ = C.lane >> 5, cl_ = C.lane & 31; \
    _Pragma("unroll") for (int r_ = 0; r_ < 16; ++r_) { const int rl_ = crow(r_, hi_); \
        { const int rloc = rl_, cloc = cl_; const float val = c00[r_]; __VA_ARGS__ } \
        { const int rloc = rl_, cloc = 32 + cl_; const float val = c01[r_]; __VA_ARGS__ } \
        { const int rloc = 32 + rl_, cloc = cl_; const float val = c10[r_]; __VA_ARGS__ } \
        { const int rloc = 32 + rl_, cloc = 32 + cl_; const float val = c11[r_]; __VA_ARGS__ } } } while (0)

__device__ __forceinline__ void transpose_item(const float* W, int ldw, bf16_t* WT, int ldt, int k0, int n0src, int drow0, LAS float* scr, int lane) {
#pragma unroll 8
    for (int i = 0; i < 32; ++i) { const int kk = 2 * i + (lane >> 5); scr[kk * 33 + (lane & 31)] = W[(size_t)(k0 + kk) * ldw + n0src + (lane & 31)]; }
    asm volatile("s_waitcnt lgkmcnt(0)" ::: "memory");
    const int c = lane & 7;
#pragma unroll
    for (int j = 0; j < 4; ++j) { const int n = (lane >> 3) + 8 * j; const LAS float* s = scr + (8 * c) * 33 + n;
        u32x4 o; o.x = pk2(s[0 * 33], s[1 * 33]); o.y = pk2(s[2 * 33], s[3 * 33]); o.z = pk2(s[4 * 33], s[5 * 33]); o.w = pk2(s[6 * 33], s[7 * 33]);
        *(u32x4*)(WT + (size_t)(drow0 + n) * ldt + k0 + 8 * c) = o; }
    asm volatile("s_waitcnt lgkmcnt(0)" ::: "memory");
}

__device__ __forceinline__ void s5_tables(const Ctx& C, int g) {
    LAS float* L = (LAS float*)C.lds;
    LAS float* apr = L; LAS float* api = L + 1088; LAS float* bbr = L + 2176; LAS float* bbi = L + 3200;
    LAS float* cr = L + 4224; LAS float* ci = L + 5248; LAS float* Kt = L + 6272;
    const int tid = C.tid;
    if (tid < 64) {
        const int p = tid;
        const float lr = C.lam_re_()[g * 64 + p], li = C.lam_im_()[g * 64 + p], dl = expf(C.log_step_()[g]);
        const float mag = expf(lr * dl), ang = li * dl;
        const float a1r = mag * cosf(ang), a1i = mag * sinf(ang);
        float pr = 1.f, pi = 0.f;
        for (int j = 0; j <= 16; ++j) { apr[j * 64 + p] = pr; api[j * 64 + p] = pi; const float nr = pr * a1r - pi * a1i, ni = pr * a1i + pi * a1r; pr = nr; pi = ni; }
        C.S5A_()[(g * 64 + p) * 2 + 0] = apr[16 * 64 + p]; C.S5A_()[(g * 64 + p) * 2 + 1] = api[16 * 64 + p];
        const float den = lr * lr + li * li, nre = a1r - 1.0f;
        const float cre = (nre * lr + a1i * li) / den, cim = (a1i * lr - nre * li) / den;
        for (int h = 0; h < 16; ++h) { const float br = C.b_re_()[(g * 64 + p) * 16 + h], bi = C.b_im_()[(g * 64 + p) * 16 + h];
            bbr[p * 16 + h] = cre * br - cim * bi; bbi[p * 16 + h] = cre * bi + cim * br; }
    }
    for (int idx = tid; idx < 1024; idx += 512) { const int h = idx >> 6, p = idx & 63; cr[idx] = C.c_re_()[(g * 16 + h) * 64 + p]; ci[idx] = C.c_im_()[(g * 16 + h) * 64 + p]; }
    __syncthreads();
    for (int idx = tid; idx < 4096; idx += 512) { const int j = idx >> 8, h = (idx >> 4) & 15, hp = idx & 15; float s = 0.f;
        for (int p = 0; p < 64; ++p) { const float c_r = cr[h * 64 + p], c_i = ci[h * 64 + p], ar = apr[j * 64 + p], ai = api[j * 64 + p];
            const float mr = c_r * ar - c_i * ai, mi = c_r * ai + c_i * ar; s += mr * bbr[p * 16 + hp] - mi * bbi[p * 16 + hp]; }
        Kt[idx] = s; }
    __syncthreads();
    for (int ch = tid; ch < 256 * 48; ch += 512) { const int n = ch / 48, kc = ch - n * 48, k0 = kc * 8, tl = n >> 4, h = n & 15; float v[8];
        if (k0 < 256) { const int sl = k0 >> 4, hp0 = k0 & 15;
#pragma unroll
            for (int i = 0; i < 8; ++i) v[i] = (tl >= sl) ? Kt[((tl - sl) * 16 + h) * 16 + hp0 + i] : 0.f;
        } else {
#pragma unroll
            for (int i = 0; i < 8; ++i) { const int q = k0 - 256 + i, p = q & 63, im = q >> 6, j = tl + 1; const float c_r = cr[h * 64 + p], c_i = ci[h * 64 + p], ar = apr[j * 64 + p], ai = api[j * 64 + p];
                v[i] = im ? -(c_r * ai + c_i * ar) : (c_r * ar - c_i * ai); }
        }
        u32x4 o; o.x = pk2(v[0], v[1]); o.y = pk2(v[2], v[3]); o.z = pk2(v[4], v[5]); o.w = pk2(v[6], v[7]);
        *(u32x4*)(C.S5W_() + ((size_t)(g * 256 + n)) * UXK + k0) = o; }
    for (int ch = tid; ch < 128 * 32; ch += 512) { const int n = ch >> 5, k0 = (ch & 31) * 8, sl = k0 >> 4, hp0 = k0 & 15, p = n & 63, im = n >> 6, j = 15 - sl; float v[8];
        const float ar = apr[j * 64 + p], ai = api[j * 64 + p];
#pragma unroll
        for (int i = 0; i < 8; ++i) { const float br = bbr[p * 16 + hp0 + i], bi = bbi[p * 16 + hp0 + i]; v[i] = im ? (ar * bi + ai * br) : (ar * br - ai * bi); }
        u32x4 o; o.x = pk2(v[0], v[1]); o.y = pk2(v[2], v[3]); o.z = pk2(v[4], v[5]); o.w = pk2(v[6], v[7]);
        *(u32x4*)(C.S5S_() + ((size_t)(g * 128 + n)) * 256 + k0) = o; }
    __syncthreads();
}

__device__ __forceinline__ void ph_prologue(const Ctx& C) {
    for (int g = C.wgid; g < NG; g += C.G) s5_tables(C, g);
    __syncthreads();
    LAS float* scr = (LAS float*)C.lds + C.wave * 2112;
    constexpr int I_QKV = 16 * 48, I_U = 16 * 16, I_GLU = 8 * 16, I_OUT = 16 * 32, I_GU1 = 16 * 16, I_D1 = 8 * 32;
    constexpr int NITEMS = I_QKV + I_U + I_GLU + I_OUT + NE * 2 * I_GU1 + NE * I_D1;
    for (int it = C.gw; it < NITEMS; it += C.NGW) {
        int r = it;
        if (r < I_QKV) { const int kb = r / 48, nb = r % 48; transpose_item(C.w_in_(), INC, C.Win_(), DM, 64 * kb, 32 * nb, 32 * nb, scr, C.lane); continue; } r -= I_QKV;
        if (r < I_U) { const int kb = r / 16, nb = r % 16; transpose_item(C.w_in_(), INC, C.Win_(), DM, 64 * kb, 1544 + 32 * nb, 1536 + 32 * nb, scr, C.lane); continue; } r -= I_U;
        if (r < I_GLU) { const int kb = r / 16, nb = r % 16; transpose_item(C.w_glu_(), SWD, C.Wglu_(), SWD, 64 * kb, 32 * nb, 32 * nb, scr, C.lane); continue; } r -= I_GLU;
        if (r < I_OUT) { const int kb = r / 32, nb = r % 32; transpose_item(C.w_out_(), DM, C.Wout_(), DM, 64 * kb, 32 * nb, 32 * nb, scr, C.lane); continue; } r -= I_OUT;
        if (r < NE * 2 * I_GU1) { const int e = r / (2 * I_GU1), r2 = r % (2 * I_GU1), up = r2 / I_GU1, r3 = r2 % I_GU1, kb = r3 / 16, nb = r3 % 16;
            const float* W = (up ? C.w_up_() : C.w_gate_()) + (size_t)e * DM * DE; const int n0 = 32 * nb; const int drow = 256 * (n0 >> 7) + 128 * up + (n0 & 127);
            transpose_item(W, DE, C.Wgu_() + (size_t)e * 1024 * 1024, DM, 64 * kb, n0, drow, scr, C.lane); continue; } r -= NE * 2 * I_GU1;
        { const int e = r / I_D1, r2 = r % I_D1, kb = r2 / 32, nb = r2 % 32;
            transpose_item(C.w_down_() + (size_t)e * DE * DM, DM, C.Wd_() + (size_t)e * DM * DE, DE, 64 * kb, 32 * nb, 32 * nb, scr, C.lane); }
    }
    float wf[4][4][8];
#pragma unroll
    for (int j = 0; j < 4; ++j)
#pragma unroll
        for (int i = 0; i < 4; ++i)
#pragma unroll
            for (int hh = 0; hh < 8; ++hh) wf[j][i][hh] = C.w_in_()[(size_t)(256 * j + 4 * C.lane + i) * INC + 1536 + hh];
    for (int row = C.gw; row < T; row += C.NGW) {
        const f32x4* xr = (const f32x4*)(C.x_() + (size_t)row * DM) + C.lane;
        f32x4 v[4]; float fl[8];
#pragma unroll
        for (int hh = 0; hh < 8; ++hh) fl[hh] = 0.f;
#pragma unroll
        for (int j = 0; j < 4; ++j) { v[j] = xr[64 * j];
#pragma unroll
            for (int i = 0; i < 4; ++i)
#pragma unroll
                for (int hh = 0; hh < 8; ++hh) fl[hh] += v[j][i] * wf[j][i][hh]; }
        u32x2* o8 = (u32x2*)(C.XB_() + (size_t)row * DM) + C.lane;
#pragma unroll
        for (int j = 0; j < 4; ++j) { u32x2 w; w.x = pk2(v[j][0], v[j][1]); w.y = pk2(v[j][2], v[j][3]); o8[64 * j] = w; }
#pragma unroll
        for (int hh = 0; hh < 8; ++hh) fl[hh] = wave_sum(fl[hh]);
        float mine = 0.f;
#pragma unroll
        for (int hh = 0; hh < 8; ++hh) mine = (C.lane == hh) ? fl[hh] : mine;
        if (C.lane < 8) { const float z = mine + C.b_fgate_()[C.lane]; const float ls = fminf(z, 0.f) - log1pf(__expf(-fabsf(z)));
            const int b = row / SEQ, t = row % SEQ; C.LOGF_()[((size_t)(b * NH + C.lane)) * SEQ + t] = ls; }
    }
}

__device__ __forceinline__ void ph_cumscan(const Ctx& C) {
    for (int s = C.gw; s < BATCH * NH; s += C.NGW) {
        const float* src = C.LOGF_() + (size_t)s * SEQ + 32 * C.lane; float v[32];
#pragma unroll
        for (int i = 0; i < 8; ++i) { const f32x4 t = *(const f32x4*)(src + 4 * i); v[4 * i] = t[0]; v[4 * i + 1] = t[1]; v[4 * i + 2] = t[2]; v[4 * i + 3] = t[3]; }
#pragma unroll
        for (int i = 1; i < 32; ++i) v[i] += v[i - 1];
        float tot = v[31], inc = tot;
#pragma unroll
        for (int o = 1; o < 64; o <<= 1) { const float t = __shfl_up(inc, o); if (C.lane >= o) inc += t; }
        const float off = inc - tot;
        float* dst = C.CUM_() + (size_t)s * SEQ + 32 * C.lane;
#pragma unroll
        for (int i = 0; i < 8; ++i) { f32x4 t; t[0] = (v[4 * i] + off) * LOG2E; t[1] = (v[4 * i + 1] + off) * LOG2E; t[2] = (v[4 * i + 2] + off) * LOG2E; t[3] = (v[4 * i + 3] + off) * LOG2E; *(f32x4*)(dst + 4 * i) = t; }
    }
}
__device__ __forceinline__ void ph_gemm1(const Ctx& C) {
    const int hi = C.lane >> 5, r32 = C.lane & 31;
    for (int id = C.gw; id < 512 * 32; id += C.NGW) {
        const int mb = id >> 5, nb = id & 31;
        const bf16_t* a0 = C.XB_() + (size_t)(mb * 64 + r32) * DM + 8 * hi; const bf16_t* b0 = C.Win_() + (size_t)(nb * 64 + r32) * DM + 8 * hi;
        f32x16 c00, c01, c10, c11; wave_gemm64(a0, a0 + 32 * DM, b0, b0 + 32 * DM, DM, c00, c01, c10, c11);
        FOR_ACC(c00, c01, c10, c11, {
            const int row = mb * 64 + rloc, col = nb * 64 + cloc;
            if (col < 512) C.Q_()[(size_t)row * AW + col] = (bf16_t)f2bf(val * C2);
            else if (col < 1024) C.K_()[(size_t)row * AW + col - 512] = (bf16_t)f2bf(val);
            else if (col < 1536) C.V_()[(size_t)row * AW + col - 1024] = (bf16_t)f2bf(val);
            else { const int cu = col - 1536, g = cu >> 4, h = cu & 15; C.UX_()[((size_t)(g * 2048 + (row >> 4))) * UXK + (row & 15) * 16 + h] = (bf16_t)f2bf(val); }
        });
    }
}

__device__ __forceinline__ void attn_wave_unit(const Ctx& C, int bh, int qb) {
    const int lane = C.lane, r32 = lane & 31, hi = lane >> 5, b = bh >> 3, hd = bh & 7;
    const size_t rowbase = (size_t)b * SEQ; const int q0 = qb * 32;
    const bf16_t* Qp = C.Q_() + (rowbase + q0 + r32) * AW + hd * 64 + 8 * hi;
    bf16x8 qr[4];
#pragma unroll
    for (int d0 = 0; d0 < 4; ++d0) qr[d0] = *(const bf16x8*)(Qp + 16 * d0);
    const float* cum = C.CUM_() + (size_t)bh * SEQ;
    const float cq = cum[q0 + r32];
    float m = -INFINITY, l = 0.f; f32x16 o0 = (f32x16){}, o1 = (f32x16){};
    for (int kt = 0; kt <= qb; ++kt) {
        const int kv0 = kt * 32;
        const bf16_t* Kp = C.K_() + (rowbase + kv0 + r32) * AW + hd * 64 + 8 * hi;
        f32x16 s = (f32x16){};
#pragma unroll
        for (int d0 = 0; d0 < 4; ++d0) { const bf16x8 kf = *(const bf16x8*)(Kp + 16 * d0); s = __builtin_amdgcn_mfma_f32_32x32x16_bf16(kf, qr[d0], s, 0, 0, 0); }
#pragma unroll
        for (int g = 0; g < 4; ++g) { const f32x4 ck = *(const f32x4*)(cum + kv0 + 8 * g + 4 * hi);
#pragma unroll
            for (int i = 0; i < 4; ++i) { const int r = 4 * g + i; float sv = s[r] + (cq - ck[i]); if (kt == qb && (8 * g + 4 * hi + i) > r32) sv = -INFINITY; s[r] = sv; } }
        float mx = s[0];
#pragma unroll
        for (int r = 1; r < 16; ++r) mx = fmaxf(mx, s[r]);
        mx = fmaxf(mx, __shfl_xor(mx, 32));
        const float mn = fmaxf(m, mx), alpha = __builtin_amdgcn_exp2f(m - mn); m = mn;
        float psum = 0.f;
#pragma unroll
        for (int r = 0; r < 16; ++r) { s[r] = __builtin_amdgcn_exp2f(s[r] - mn); psum += s[r]; }
        l = l * alpha + psum;
#pragma unroll
        for (int r = 0; r < 16; ++r) { const float ar = __shfl(alpha, crow(r, hi)); o0[r] *= ar; o1[r] *= ar; }
        bf16x8 pa0, pa1;
#pragma unroll
        for (int j = 0; j < 8; ++j) { pa0[j] = (short)f2bf(s[j]); pa1[j] = (short)f2bf(s[8 + j]); }
        const bf16_t* Vp = C.V_() + (rowbase + kv0) * AW + hd * 64 + r32;
#pragma unroll
        for (int sidx = 0; sidx < 2; ++sidx) {
            bf16x8 vf0, vf1;
#pragma unroll
            for (int j = 0; j < 8; ++j) { const int kvl = 16 * sidx + 8 * (j >> 2) + 4 * hi + (j & 3); vf0[j] = (short)Vp[(size_t)kvl * AW]; vf1[j] = (short)Vp[(size_t)kvl * AW + 32]; }
            o0 = __builtin_amdgcn_mfma_f32_32x32x16_bf16(sidx ? pa1 : pa0, vf0, o0, 0, 0, 0);
            o1 = __builtin_amdgcn_mfma_f32_32x32x16_bf16(sidx ? pa1 : pa0, vf1, o1, 0, 0, 0);
        }
    }
    const float ltot = l + __shfl_xor(l, 32), inv = 1.0f / ltot;
#pragma unroll
    for (int r = 0; r < 16; ++r) { const float ir = __shfl(inv, crow(r, hi)); const size_t row = rowbase + q0 + crow(r, hi);
        C.YCAT_()[row * DM + hd * 64 + r32] = (bf16_t)f2bf(o0[r] * ir); C.YCAT_()[row * DM + hd * 64 + 32 + r32] = (bf16_t)f2bf(o1[r] * ir); }
}
__device__ __forceinline__ void ph_attention(const Ctx& C) {
    for (int u = C.gw; u < 128 * 64; u += C.NGW) { const int qb = 63 - (u >> 7), bh = u & 127; attn_wave_unit(C, bh, qb); }
}
__device__ __forceinline__ void ph_s5a(const Ctx& C) {
    const int hi = C.lane >> 5, r32 = C.lane & 31;
    for (int id = C.gw; id < 2048; id += C.NGW) {
        const int g = id >> 6, mb = (id >> 1) & 31, nb = id & 1;
        const bf16_t* a0 = C.UX_() + (size_t)(g * 2048 + mb * 64 + r32) * UXK + 8 * hi; const bf16_t* b0 = C.S5S_() + (size_t)(g * 128 + nb * 64 + r32) * 256 + 8 * hi;
        f32x16 c00, c01, c10, c11; wave_gemm64(a0, a0 + 32 * UXK, b0, b0 + 32 * 256, 256, c00, c01, c10, c11);
        FOR_ACC(c00, c01, c10, c11, { C.SLOC_()[(size_t)(g * 2048 + mb * 64 + rloc) * 128 + nb * 64 + cloc] = val; });
    }
}
__device__ __forceinline__ void ph_s5b(const Ctx& C) {
    for (int idx = C.wgid * 512 + C.tid; idx < NG * BATCH * SP; idx += C.G * 512) {
        const int g = idx >> 10, b = (idx >> 6) & 15, p = idx & 63;
        const float ar = C.S5A_()[(g * 64 + p) * 2], ai = C.S5A_()[(g * 64 + p) * 2 + 1];
        float xr = 0.f, xi = 0.f;
        for (int c = 0; c < NCH; ++c) { const size_t row = (size_t)g * 2048 + b * 128 + c;
            C.UX_()[row * UXK + 256 + p] = (bf16_t)f2bf(xr); C.UX_()[row * UXK + 320 + p] = (bf16_t)f2bf(xi);
            const float sr = C.SLOC_()[row * 128 + p], si = C.SLOC_()[row * 128 + 64 + p];
            const float nr = ar * xr - ai * xi + sr, ni = ar * xi + ai * xr + si; xr = nr; xi = ni; }
    }
}
__device__ __forceinline__ void ph_s5c(const Ctx& C) {
    const int hi = C.lane >> 5, r32 = C.lane & 31;
    for (int id = C.gw; id < 4096; id += C.NGW) {
        const int g = id >> 7, mb = (id >> 2) & 31, nb = id & 3;
        const bf16_t* a0 = C.UX_() + (size_t)(g * 2048 + mb * 64 + r32) * UXK + 8 * hi; const bf16_t* b0 = C.S5W_() + (size_t)(g * 256 + nb * 64 + r32) * UXK + 8 * hi;
        f32x16 c00, c01, c10, c11; wave_gemm64(a0, a0 + 32 * UXK, b0, b0 + 32 * UXK, UXK, c00, c01, c10, c11);
        FOR_ACC(c00, c01, c10, c11, {
            const int row = mb * 64 + rloc, n = nb * 64 + cloc, tl = n >> 4, h = n & 15;
            const float u = bf2f(C.UX_()[(size_t)(g * 2048 + row) * UXK + n]);
            const float yv = val + C.dskip_()[g * 16 + h] * u;
            C.Y_()[((size_t)row * 16 + tl) * SWD + g * 16 + h] = (bf16_t)f2bf(gelu_tanh(yv));
        });
    }
}
__device__ __forceinline__ void ph_glu(const Ctx& C) {
    const int hi = C.lane >> 5, r32 = C.lane & 31;
    for (int id = C.gw; id < 512 * 8; id += C.NGW) {
        const int mb = id >> 3, nb = id & 7;
        const bf16_t* a0 = C.Y_() + (size_t)(mb * 64 + r32) * SWD + 8 * hi; const bf16_t* b0 = C.Wglu_() + (size_t)(nb * 64 + r32) * SWD + 8 * hi;
        f32x16 c00, c01, c10, c11; wave_gemm64(a0, a0 + 32 * SWD, b0, b0 + 32 * SWD, SWD, c00, c01, c10, c11);
        FOR_ACC(c00, c01, c10, c11, {
            const int row = mb * 64 + rloc, col = nb * 64 + cloc;
            const float yv = bf2f(C.Y_()[(size_t)row * SWD + col]);
            C.YCAT_()[(size_t)row * DM + 512 + col] = (bf16_t)f2bf(yv * sigmoidf_(val + C.b_glu_()[col]));
        });
    }
}
__device__ __forceinline__ void ph_norm(const Ctx& C) {
    for (int row = C.gw; row < T; row += C.NGW) {
        bf16_t* p = C.YCAT_() + (size_t)row * DM + 16 * C.lane;
        const u32x4 w0 = *(const u32x4*)p, w1 = *(const u32x4*)(p + 8); float v[16];
#pragma unroll
        for (int i = 0; i < 4; ++i) { v[2 * i] = bf2f((unsigned short)(w0[i] & 0xffff)); v[2 * i + 1] = bf2f((unsigned short)(w0[i] >> 16)); v[8 + 2 * i] = bf2f((unsigned short)(w1[i] & 0xffff)); v[8 + 2 * i + 1] = bf2f((unsigned short)(w1[i] >> 16)); }
        float ss = 0.f;
#pragma unroll
        for (int i = 0; i < 16; ++i) ss += v[i] * v[i];
#pragma unroll
        for (int o = 1; o < 32; o <<= 1) ss += __shfl_xor(ss, o);
        const float sc = 1.0f / sqrtf(ss * (1.0f / 512.0f) + RMS_EPS);
        const float* gp = (C.lane < 32) ? (C.attn_g_() + 16 * C.lane) : (C.ssm_g_() + 16 * (C.lane - 32));
#pragma unroll
        for (int i = 0; i < 16; ++i) v[i] = v[i] * sc * gp[i];
        u32x4 o0, o1;
#pragma unroll
        for (int i = 0; i < 4; ++i) { o0[i] = pk2(v[2 * i], v[2 * i + 1]); o1[i] = pk2(v[8 + 2 * i], v[8 + 2 * i + 1]); }
        *(u32x4*)p = o0; *(u32x4*)(p + 8) = o1;
    }
}
__device__ __forceinline__ void ph_wout(const Ctx& C) {
    const int hi = C.lane >> 5, r32 = C.lane & 31;
    for (int id = C.gw; id < 512 * 16; id += C.NGW) {
        const int mb = id >> 4, nb = id & 15;
        const bf16_t* a0 = C.YCAT_() + (size_t)(mb * 64 + r32) * DM + 8 * hi; const bf16_t* b0 = C.Wout_() + (size_t)(nb * 64 + r32) * DM + 8 * hi;
        f32x16 c00, c01, c10, c11; wave_gemm64(a0, a0 + 32 * DM, b0, b0 + 32 * DM, DM, c00, c01, c10, c11);
        FOR_ACC(c00, c01, c10, c11, { C.out_()[(size_t)(mb * 64 + rloc) * DM + nb * 64 + cloc] = val; });
    }
}
__device__ __forceinline__ void ph_ln1(const Ctx& C) {
    for (int row = C.gw; row < T; row += C.NGW) {
        const f32x4* xr = (const f32x4*)(C.x_() + (size_t)row * DM) + C.lane; f32x4* mr = (f32x4*)(C.out_() + (size_t)row * DM) + C.lane;
        f32x4 v[4]; float s = 0.f;
#pragma unroll
        for (int j = 0; j < 4; ++j) { v[j] = xr[64 * j] * ALPHA + mr[64 * j]; s += (v[j][0] + v[j][1]) + (v[j][2] + v[j][3]); }
        const float mean = wave_sum(s) * (1.0f / DM); float q = 0.f;
#pragma unroll
        for (int j = 0; j < 4; ++j) { v[j] = v[j] - mean; q += (v[j][0] * v[j][0] + v[j][1] * v[j][1]) + (v[j][2] * v[j][2] + v[j][3] * v[j][3]); }
        const float rstd = 1.0f / sqrtf(wave_sum(q) * (1.0f / DM) + LN_EPS);
        u32x2* hb = (u32x2*)(C.HB_() + (size_t)row * DM) + C.lane;
#pragma unroll
        for (int j = 0; j < 4; ++j) { const f32x4 g = *((const f32x4*)C.ln1_g_() + C.lane + 64 * j), bb = *((const f32x4*)C.ln1_b_() + C.lane + 64 * j);
            const f32x4 o = v[j] * rstd * g + bb; mr[64 * j] = o; u32x2 w; w.x = pk2(o[0], o[1]); w.y = pk2(o[2], o[3]); hb[64 * j] = w; }
    }
}
__device__ __forceinline__ void ph_router(const Ctx& C) {
    for (int tok = C.gw; tok < T; tok += C.NGW) {
        const f32x4* hr = (const f32x4*)(C.out_() + (size_t)tok * DM) + C.lane;
        float acc[36];
#pragma unroll
        for (int i = 0; i < 36; ++i) acc[i] = 0.f;
#pragma unroll
        for (int j = 0; j < 4; ++j) { const f32x4 hv = hr[64 * j];
#pragma unroll
            for (int i = 0; i < 4; ++i) { const int k = 256 * j + 4 * C.lane + i; const float hx = hv[i];
                const f32x4 wg = *(const f32x4*)(C.w_rg_() + (size_t)k * 4);
#pragma unroll
                for (int c = 0; c < 4; ++c) acc[c] += hx * wg[c];
#pragma unroll
                for (int c4 = 0; c4 < 8; ++c4) { const f32x4 we = *(const f32x4*)(C.w_re_() + (size_t)k * 32 + 4 * c4);
#pragma unroll
                    for (int c = 0; c < 4; ++c) acc[4 + 4 * c4 + c] += hx * we[c]; } } }
#pragma unroll
        for (int i = 0; i < 36; ++i) acc[i] = wave_sum(acc[i]);
#pragma unroll
        for (int c = 0; c < 4; ++c) acc[c] += C.b_rg_()[c];
#pragma unroll
        for (int c = 0; c < 32; ++c) acc[4 + c] += C.b_re2_()[c];
        int gi = 0; float gm = acc[0];
#pragma unroll
        for (int c = 1; c < 4; ++c) if (acc[c] > gm) { gm = acc[c]; gi = c; }
        float gs = 0.f;
#pragma unroll
        for (int c = 0; c < 4; ++c) gs += __expf(acc[c] - gm);
        const float gp = 1.0f / gs;
        float el[8];
#pragma unroll
        for (int i = 0; i < 8; ++i) el[i] = (gi == 0) ? acc[4 + i] : (gi == 1) ? acc[12 + i] : (gi == 2) ? acc[20 + i] : acc[28 + i];
        int i1 = 0; float l1 = el[0];
#pragma unroll
        for (int i = 1; i < 8; ++i) if (el[i] > l1) { l1 = el[i]; i1 = i; }
        int i2 = -1; float l2 = -INFINITY;
#pragma unroll
        for (int i = 0; i < 8; ++i) if (i != i1 && el[i] > l2) { l2 = el[i]; i2 = i; }
        const float p1 = 1.0f / (1.0f + __expf(l2 - l1)), p2 = 1.0f - p1;
        if (C.lane == 0) {
            const int e1 = gi * 8 + i1, e2 = gi * 8 + i2;
            const unsigned pos1 = atomicAdd(C.ctl_() + CW_CNT + e1, 1u); C.LIST_()[(size_t)e1 * T + pos1] = 2 * tok; C.GATE_()[2 * tok] = gp * p1;
            const unsigned pos2 = atomicAdd(C.ctl_() + CW_CNT + e2, 1u); C.LIST_()[(size_t)e2 * T + pos2] = 2 * tok + 1; C.GATE_()[2 * tok + 1] = gp * p2;
        }
    }
}
struct MoeMap { int cnt, incl, excl, offc, total; };
__device__ __forceinline__ MoeMap moe_map(const Ctx& C, int tiles_per_mb) {
    MoeMap M; const int lane = C.lane;
    const int c = (lane < 32) ? (int)__hip_atomic_load(C.ctl_() + CW_CNT + lane, __ATOMIC_RELAXED, __HIP_MEMORY_SCOPE_AGENT) : 0;
    const int tl = ((c + 63) >> 6) * tiles_per_mb;
    int inc = tl, incc = c;
#pragma unroll
    for (int o = 1; o < 32; o <<= 1) { const int t1 = __shfl_up(inc, o), t2 = __shfl_up(incc, o); if ((lane & 31) >= o) { inc += t1; incc += t2; } }
    M.cnt = c; M.incl = (lane < 32) ? inc : 0x7fffffff; M.excl = inc - tl; M.offc = incc - c; M.total = __shfl(inc, 31);
    return M;
}
__device__ __forceinline__ void ph_moe_up(const Ctx& C) {
    const int lane = C.lane, hi = lane >> 5, r32 = lane & 31;
    const MoeMap M = moe_map(C, 16);
    for (int id = C.gw; id < M.total; id += C.NGW) {
        const int e = __popcll(__ballot(lane < 32 && M.incl <= id));
        const int base = id - __shfl(M.excl, e), mb = base >> 4, nb = base & 15, ce = __shfl(M.cnt, e), offe = __shfl(M.offc, e);
        const int s0 = mb * 64 + r32, s1 = s0 + 32;
        const int t0 = (s0 < ce) ? (C.LIST_()[(size_t)e * T + s0] >> 1) : 0, t1 = (s1 < ce) ? (C.LIST_()[(size_t)e * T + s1] >> 1) : 0;
        const bf16_t* a0 = C.HB_() + (size_t)t0 * DM + 8 * hi; const bf16_t* a1 = C.HB_() + (size_t)t1 * DM + 8 * hi;
        const bf16_t* b0 = C.Wgu_() + ((size_t)e * 1024 + (nb >> 2) * 256 + (nb & 3) * 32 + r32) * DM + 8 * hi;
        f32x16 c00, c01, c10, c11; wave_gemm64(a0, a1, b0, b0 + 128 * DM, DM, c00, c01, c10, c11);
#pragma unroll
        for (int r = 0; r < 16; ++r) { const int rl = crow(r, hi);
            { const int slot = mb * 64 + rl; if (slot < ce) { const float g = c00[r], u = c01[r]; C.HID_()[(size_t)(offe + slot) * DE + nb * 32 + r32] = (bf16_t)f2bf(g * sigmoidf_(g) * u); } }
            { const int slot = mb * 64 + 32 + rl; if (slot < ce) { const float g = c10[r], u = c11[r]; C.HID_()[(size_t)(offe + slot) * DE + nb * 32 + r32] = (bf16_t)f2bf(g * sigmoidf_(g) * u); } } }
    }
}
__device__ __forceinline__ void ph_moe_down(const Ctx& C) {
    const int lane = C.lane, hi = lane >> 5, r32 = lane & 31;
    const MoeMap M = moe_map(C, 16);
    for (int id = C.gw; id < M.total; id += C.NGW) {
        const int e = __popcll(__ballot(lane < 32 && M.incl <= id));
        const int base = id - __shfl(M.excl, e), mb = base >> 4, nb = base & 15, ce = __shfl(M.cnt, e), offe = __shfl(M.offc, e);
        const bf16_t* a0 = C.HID_() + (size_t)(offe + mb * 64 + r32) * DE + 8 * hi;
        const bf16_t* b0 = C.Wd_() + ((size_t)e * 1024 + nb * 64 + r32) * DE + 8 * hi;
        f32x16 c00, c01, c10, c11; wave_gemm64(a0, a0 + 32 * DE, b0, b0 + 32 * DE, DE, c00, c01, c10, c11);
        FOR_ACC(c00, c01, c10, c11, {
            const int slot = mb * 64 + rloc;
            if (slot < ce) { const int a = C.LIST_()[(size_t)e * T + slot]; const float gt = C.GATE_()[a]; C.YASG_()[(size_t)a * DM + nb * 64 + cloc] = (bf16_t)f2bf(gt * val); }
        });
    }
}
__device__ __forceinline__ void ph_final(const Ctx& C) {
    for (int row = C.gw; row < T; row += C.NGW) {
        f32x4* hr = (f32x4*)(C.out_() + (size_t)row * DM) + C.lane;
        const u32x2* ya = (const u32x2*)(C.YASG_() + (size_t)(2 * row) * DM) + C.lane; const u32x2* yb = (const u32x2*)(C.YASG_() + (size_t)(2 * row + 1) * DM) + C.lane;
        f32x4 v[4]; float s = 0.f;
#pragma unroll
        for (int j = 0; j < 4; ++j) { const u32x2 a = ya[64 * j], b = yb[64 * j];
            f32x4 m; m[0] = bf2f((unsigned short)(a.x & 0xffff)) + bf2f((unsigned short)(b.x & 0xffff)); m[1] = bf2f((unsigned short)(a.x >> 16)) + bf2f((unsigned short)(b.x >> 16));
            m[2] = bf2f((unsigned short)(a.y & 0xffff)) + bf2f((unsigned short)(b.y & 0xffff)); m[3] = bf2f((unsigned short)(a.y >> 16)) + bf2f((unsigned short)(b.y >> 16));
            v[j] = hr[64 * j] * ALPHA + m; s += (v[j][0] + v[j][1]) + (v[j][2] + v[j][3]); }
        const float mean = wave_sum(s) * (1.0f / DM); float q = 0.f;
#pragma unroll
        for (int j = 0; j < 4; ++j) { v[j] = v[j] - mean; q += (v[j][0] * v[j][0] + v[j][1] * v[j][1]) + (v[j][2] * v[j][2] + v[j][3] * v[j][3]); }
        const float rstd = 1.0f / sqrtf(wave_sum(q) * (1.0f / DM) + LN_EPS);
#pragma unroll
        for (int j = 0; j < 4; ++j) { const f32x4 g = *((const f32x4*)C.ln2_g_() + C.lane + 64 * j), bb = *((const f32x4*)C.ln2_b_() + C.lane + 64 * j); hr[64 * j] = v[j] * rstd * g + bb; }
    }
}

constexpr int NPHASE = 13;
constexpr int LDS_BYTES = 81920;
template <int PH> __global__ void __launch_bounds__(512, 2) fwd_kernel(Args args) {
    extern __shared__ __attribute__((aligned(16))) unsigned char lds[];
    Ctx C;
    C.tid = threadIdx.x; C.lane = C.tid & 63; C.wave = __builtin_amdgcn_readfirstlane(C.tid >> 6); C.wgid = blockIdx.x; C.G = gridDim.x;
    C.gw = C.wgid * 8 + C.wave; C.NGW = C.G * 8; C.lds = (LAS unsigned char*)lds;
    C.a = &args;
    if constexpr (PH == 0) ph_prologue(C);
    if constexpr (PH == 1) { ph_cumscan(C); ph_gemm1(C); }
    if constexpr (PH == 2) { ph_attention(C); ph_s5a(C); }
    if constexpr (PH == 3) ph_s5b(C);
    if constexpr (PH == 4) ph_s5c(C);
    if constexpr (PH == 5) ph_glu(C);
    if constexpr (PH == 6) ph_norm(C);
    if constexpr (PH == 7) ph_wout(C);
    if constexpr (PH == 8) ph_ln1(C);
    if constexpr (PH == 9) ph_router(C);
    if constexpr (PH == 10) ph_moe_up(C);
    if constexpr (PH == 11) ph_moe_down(C);
    if constexpr (PH == 12) ph_final(C);
}
template <int PH> static void launch_ph(int grid, hipStream_t stream, const Args& a) {
    hipLaunchKernelGGL(fwd_kernel<PH>, dim3(grid), dim3(512), PH == 0 ? LDS_BYTES : 0, stream, a);
}

extern "C" void kernel_launch(void* const* d_in, const int* in_sizes, int n_in, void* d_out, int out_size, void* d_ws, size_t ws_size, hipStream_t stream) {
    static int grid = 0;
    if (grid == 0) {
        if (n_in != 27 || in_sizes[0] != T * DM || out_size != T * DM || ws_size < WS_END) {
            fprintf(stderr, "kernel_launch: unexpected shapes: n_in %d in0 %d out %d ws %zu\n", n_in, n_in > 0 ? in_sizes[0] : -1, out_size, ws_size); grid = -1; return; }
        int dev = 0, cus = 0;
        if (hipGetDevice(&dev) != hipSuccess || hipDeviceGetAttribute(&cus, hipDeviceAttributeMultiprocessorCount, dev) != hipSuccess) { grid = -1; return; }
        if (hipFuncSetAttribute((const void*)fwd_kernel<0>, hipFuncAttributeMaxDynamicSharedMemorySize, LDS_BYTES) != hipSuccess) { fprintf(stderr, "kernel_launch: hipFuncSetAttribute failed\n"); grid = -1; return; }
        grid = cus > 0 ? cus : 256;
    }
    if (grid < 0) return;
    (void)hipMemsetAsync((char*)d_ws + WS_CTL, 0, CTL_BYTES, stream);
    Args a{};
    for (int i = 0; i < 27; ++i) a.in[i] = (const float*)d_in[i];
    a.out = (float*)d_out; a.ws = (unsigned char*)d_ws;
    a.ph_lo = 0; a.ph_hi = NPHASE;
    launch_ph<0>(grid, stream, a); launch_ph<1>(grid, stream, a); launch_ph<2>(grid, stream, a); launch_ph<3>(grid, stream, a); launch_ph<4>(grid, stream, a);
    launch_ph<5>(grid, stream, a); launch_ph<6>(grid, stream, a); launch_ph<7>(grid, stream, a); launch_ph<8>(grid, stream, a); launch_ph<9>(grid, stream, a);
    launch_ph<10>(grid, stream, a); launch_ph<11>(grid, stream, a); launch_ph<12>(grid, stream, a);
}
```

```cpp
#include <hip/hip_runtime.h>
#include <cstdint>
#include <cstdio>

#define LAS __attribute__((address_space(3)))
typedef unsigned short bf16_t;
typedef short bf16x8 __attribute__((ext_vector_type(8)));
typedef float f32x4 __attribute__((ext_vector_type(4)));
typedef float f32x16 __attribute__((ext_vector_type(16)));
typedef unsigned u32x4 __attribute__((ext_vector_type(4)));
typedef unsigned u32x2 __attribute__((ext_vector_type(2)));

constexpr int BATCH = 16, SEQ = 2048, T = BATCH * SEQ, DM = 1024;
constexpr int AW = 512, NH = 8, HD = 64, SWD = 512, SGC = 16, NG = 32, SP = 64, INC = 2056;
constexpr int NE = 32, DE = 512;
constexpr int TC = 16, NCH = SEQ / TC, UXK = 384;
constexpr float ALPHA = 1.189207115002721f;
constexpr float LN_EPS = 1e-5f, RMS_EPS = 1e-6f;
constexpr float LOG2E = 1.4426950408889634f;
constexpr float C2 = 0.125f * LOG2E;

constexpr size_t MiB = 1u << 20;
constexpr size_t WS_CTL = 0, CTL_BYTES = 1 * MiB;
constexpr size_t WS_WIN = 2 * MiB;
constexpr size_t WS_WGLU = 6 * MiB;
constexpr size_t WS_WOUT = 7 * MiB;
constexpr size_t WS_S5S = 9 * MiB;
constexpr size_t WS_S5W = 11 * MiB;
constexpr size_t WS_S5A = 17 * MiB;
constexpr size_t WS_WGU = 18 * MiB;
constexpr size_t WS_WD = 82 * MiB;
constexpr size_t WS_XB = 114 * MiB;
constexpr size_t WS_HID = WS_XB;
constexpr size_t WS_Q = 179 * MiB, WS_K = 211 * MiB, WS_V = 243 * MiB;
constexpr size_t WS_UX = 275 * MiB;
constexpr size_t WS_YASG = 179 * MiB;
constexpr size_t WS_YCAT = 323 * MiB;
constexpr size_t WS_Y = 387 * MiB;
constexpr size_t WS_HB = 419 * MiB;
constexpr size_t WS_SLOC = WS_HB;
constexpr size_t WS_CUM = 483 * MiB;
constexpr size_t WS_LOGF = 484 * MiB;
constexpr size_t WS_GATE = 485 * MiB;
constexpr size_t WS_LIST = 486 * MiB;
constexpr size_t WS_END = 512 * MiB;
constexpr int CW_CNT = 1024;

struct Args { const float* in[27]; float* out; unsigned char* ws; int ph_lo, ph_hi; };

struct Ctx {
    int tid, lane, wave, wgid, G, gw, NGW;
    LAS unsigned char* lds;
    const Args* a;
#define CIN(name, idx) __device__ __forceinline__ const float* name() const { const float* p_ = a->in[idx]; asm volatile("" : "+s"(p_)); return p_; }
    CIN(x_, 0) CIN(w_in_, 1) CIN(b_fgate_, 2) CIN(lam_re_, 3) CIN(lam_im_, 4) CIN(log_step_, 5) CIN(b_re_, 6) CIN(b_im_, 7) CIN(c_re_, 8) CIN(c_im_, 9) CIN(dskip_, 10)
    CIN(w_glu_, 11) CIN(b_glu_, 12) CIN(attn_g_, 13) CIN(ssm_g_, 14) CIN(w_out_, 15) CIN(ln1_g_, 16) CIN(ln1_b_, 17) CIN(w_rg_, 18) CIN(b_rg_, 19) CIN(w_re_, 20) CIN(b_re2_, 21)
    CIN(w_gate_, 22) CIN(w_up_, 23) CIN(w_down_, 24) CIN(ln2_g_, 25) CIN(ln2_b_, 26)
#undef CIN
#define CWS(type, name, off) __device__ __forceinline__ type* name() const { unsigned char* p_ = a->ws; asm volatile("" : "+s"(p_)); return (type*)(p_ + (off)); }
    CWS(unsigned, ctl_, WS_CTL) CWS(bf16_t, Win_, WS_WIN) CWS(bf16_t, Wglu_, WS_WGLU) CWS(bf16_t, Wout_, WS_WOUT) CWS(bf16_t, S5S_, WS_S5S) CWS(bf16_t, S5W_, WS_S5W)
    CWS(bf16_t, Wgu_, WS_WGU) CWS(bf16_t, Wd_, WS_WD) CWS(bf16_t, XB_, WS_XB) CWS(bf16_t, HID_, WS_HID) CWS(bf16_t, Q_, WS_Q) CWS(bf16_t, K_, WS_K) CWS(bf16_t, V_, WS_V)
    CWS(bf16_t, UX_, WS_UX) CWS(bf16_t, YASG_, WS_YASG) CWS(bf16_t, YCAT_, WS_YCAT) CWS(bf16_t, Y_, WS_Y) CWS(bf16_t, HB_, WS_HB)
    CWS(float, S5A_, WS_S5A) CWS(float, SLOC_, WS_SLOC) CWS(float, CUM_, WS_CUM) CWS(float, LOGF_, WS_LOGF) CWS(float, GATE_, WS_GATE) CWS(int, LIST_, WS_LIST)
#undef CWS
    __device__ __forceinline__ float* out_() const { float* p_ = a->out; asm volatile("" : "+s"(p_)); return p_; }
};

__device__ __forceinline__ unsigned f2bf(float f) { unsigned u = __builtin_bit_cast(unsigned, f); return (u + 0x7fffu + ((u >> 16) & 1u)) >> 16; }
__device__ __forceinline__ float bf2f(unsigned short b) { return __builtin_bit_cast(float, (unsigned)b << 16); }
__device__ __forceinline__ unsigned pk2(float lo, float hi) { return f2bf(lo) | (f2bf(hi) << 16); }
__device__ __forceinline__ float wave_sum(float v) {
#pragma unroll
    for (int o = 1; o < 64; o <<= 1) v += __shfl_xor(v, o);
    return v;
}
__device__ __forceinline__ int crow(int r, int hi) { return (r & 3) + 8 * (r >> 2) + 4 * hi; }
__device__ __forceinline__ float sigmoidf_(float s) { return 1.0f / (1.0f + __expf(-s)); }
__device__ __forceinline__ float gelu_tanh(float v) { const float z = 0.7978845608028654f * (v + 0.044715f * v * v * v); const float t = 1.0f - 2.0f / (__expf(2.0f * z) + 1.0f); return 0.5f * v * (1.0f + t); }

__device__ __forceinline__ void wave_gemm64(const bf16_t* a0, const bf16_t* a1, const bf16_t* b0, const bf16_t* b1, int K,
                                            f32x16& c00, f32x16& c01, f32x16& c10, f32x16& c11) {
    c00 = (f32x16){}; c01 = (f32x16){}; c10 = (f32x16){}; c11 = (f32x16){};
    for (int k = 0; k < K; k += 32) {
        const bf16x8 A0 = *(const bf16x8*)(a0 + k), A1 = *(const bf16x8*)(a1 + k), B0 = *(const bf16x8*)(b0 + k), B1 = *(const bf16x8*)(b1 + k);
        const bf16x8 A0b = *(const bf16x8*)(a0 + k + 16), A1b = *(const bf16x8*)(a1 + k + 16), B0b = *(const bf16x8*)(b0 + k + 16), B1b = *(const bf16x8*)(b1 + k + 16);
        c00 = __builtin_amdgcn_mfma_f32_32x32x16_bf16(A0, B0, c00, 0, 0, 0);
        c01 = __builtin_amdgcn_mfma_f32_32x32x16_bf16(A0, B1, c01, 0, 0, 0);
        c10 = __builtin_amdgcn_mfma_f32_32x32x16_bf16(A1, B0, c10, 0, 0, 0);
        c11 = __builtin_amdgcn_mfma_f32_32x32x16_bf16(A1, B1, c11, 0, 0, 0);
        c00 = __builtin_amdgcn_mfma_f32_32x32x16_bf16(A0b, B0b, c00, 0, 0, 0);
        c01 = __builtin_amdgcn_mfma_f32_32x32x16_bf16(A0b, B1b, c01, 0, 0, 0);
        c10 = __builtin_amdgcn_mfma_f32_32x32x16_bf16(A1b, B0b, c10, 0, 0, 0);
        c11 = __builtin_amdgcn_mfma_f32_32x32x16_bf16(A1b, B1b, c11, 0, 0, 0);
    }
}
#define FOR_ACC(c00, c01, c10, c11, ...) do { const int hi_ = C.lane >> 5, cl_ = C.lane & 31; \
    _Pragma("unroll") for (int r_ = 0; r_ < 16; ++r_) { const int rl_ = crow(r_, hi_); \
        { const int rloc = rl_, cloc = cl_; const float val = c00[r_]; __VA_ARGS__ } \
        { const int rloc = rl_, cloc = 32 + cl_; const float val = c01[r_]; __VA_ARGS__ } \
        { const int rloc = 32 + rl_, cloc = cl_; const float val = c10[r_]; __VA_ARGS__ } \
        { const int rloc = 32 + rl_, cloc = 32 + cl_; const float val = c11[r_]; __VA_ARGS__ } } } while (0)

__device__ __forceinline__ void transpose_item(const float* W, int ldw, bf16_t* WT, int ldt, int k0, int n0src, int drow0, LAS float* scr, int lane) {
#pragma unroll 8
    for (int i = 0; i < 32; ++i) { const int kk = 2 * i + (lane >> 5); scr[kk * 33 + (lane & 31)] = W[(size_t)(k0 + kk) * ldw + n0src + (lane & 31)]; }
    asm volatile("s_waitcnt lgkmcnt(0)" ::: "memory");
    const int c = lane & 7;
#pragma unroll
    for (int j = 0; j < 4; ++j) { const int n = (lane >> 3) + 8 * j; const LAS float* s = scr + (8 * c) * 33 + n;
        u32x4 o; o.x = pk2(s[0 * 33], s[1 * 33]); o.y = pk2(s[2 * 33], s[3 * 33]); o.z = pk2(s[4 * 33], s[5 * 33]); o.w = pk2(s[6 * 33], s[7 * 33]);
        *(u32x4*)(WT + (size_t)(drow0 + n) * ldt + k0 + 8 * c) = o; }
    asm volatile("s_waitcnt lgkmcnt(0)" ::: "memory");
}

__device__ __forceinline__ void s5_tables(const Ctx& C, int g) {
    LAS float* L = (LAS float*)C.lds;
    LAS float* apr = L; LAS float* api = L + 1088; LAS float* bbr = L + 2176; LAS float* bbi = L + 3200;
    LAS float* cr = L + 4224; LAS float* ci = L + 5248; LAS float* Kt = L + 6272;
    const int tid = C.tid;
    if (tid < 64) {
        const int p = tid;
        const float lr = C.lam_re_()[g * 64 + p], li = C.lam_im_()[g * 64 + p], dl = expf(C.log_step_()[g]);
        const float mag = expf(lr * dl), ang = li * dl;
        const float a1r = mag * cosf(ang), a1i = mag * sinf(ang);
        float pr = 1.f, pi = 0.f;
        for (int j = 0; j <= 16; ++j) { apr[j * 64 + p] = pr; api[j * 64 + p] = pi; const float nr = pr * a1r - pi * a1i, ni = pr * a1i + pi * a1r; pr = nr; pi = ni; }
        C.S5A_()[(g * 64 + p) * 2 + 0] = apr[16 * 64 + p]; C.S5A_()[(g * 64 + p) * 2 + 1] = api[16 * 64 + p];
        const float den = lr * lr + li * li, nre = a1r - 1.0f;
        const float cre = (nre * lr + a1i * li) / den, cim = (a1i * lr - nre * li) / den;
        for (int h = 0; h < 16; ++h) { const float br = C.b_re_()[(g * 64 + p) * 16 + h], bi = C.b_im_()[(g * 64 + p) * 16 + h];
            bbr[p * 16 + h] = cre * br - cim * bi; bbi[p * 16 + h] = cre * bi + cim * br; }
    }
    for (int idx = tid; idx < 1024; idx += 512) { const int h = idx >> 6, p = idx & 63; cr[idx] = C.c_re_()[(g * 16 + h) * 64 + p]; ci[idx] = C.c_im_()[(g * 16 + h) * 64 + p]; }
    __syncthreads();
    for (int idx = tid; idx < 4096; idx += 512) { const int j = idx >> 8, h = (idx >> 4) & 15, hp = idx & 15; float s = 0.f;
        for (int p = 0; p < 64; ++p) { const float c_r = cr[h * 64 + p], c_i = ci[h * 64 + p], ar = apr[j * 64 + p], ai = api[j * 64 + p];
            const float mr = c_r * ar - c_i * ai, mi = c_r * ai + c_i * ar; s += mr * bbr[p * 16 + hp] - mi * bbi[p * 16 + hp]; }
        Kt[idx] = s; }
    __syncthreads();
    for (int ch = tid; ch < 256 * 48; ch += 512) { const int n = ch / 48, kc = ch - n * 48, k0 = kc * 8, tl = n >> 4, h = n & 15; float v[8];
        if (k0 < 256) { const int sl = k0 >> 4, hp0 = k0 & 15;
#pragma unroll
            for (int i = 0; i < 8; ++i) v[i] = (tl >= sl) ? Kt[((tl - sl) * 16 + h) * 16 + hp0 + i] : 0.f;
        } else {
#pragma unroll
            for (int i = 0; i < 8; ++i) { const int q = k0 - 256 + i, p = q & 63, im = q >> 6, j = tl + 1; const float c_r = cr[h * 64 + p], c_i = ci[h * 64 + p], ar = apr[j * 64 + p], ai = api[j * 64 + p];
                v[i] = im ? -(c_r * ai + c_i * ar) : (c_r * ar - c_i * ai); }
        }
        u32x4 o; o.x = pk2(v[0], v[1]); o.y = pk2(v[2], v[3]); o.z = pk2(v[4], v[5]); o.w = pk2(v[6], v[7]);
        *(u32x4*)(C.S5W_() + ((size_t)(g * 256 + n)) * UXK + k0) = o; }
    for (int ch = tid; ch < 128 * 32; ch += 512) { const int n = ch >> 5, k0 = (ch & 31) * 8, sl = k0 >> 4, hp0 = k0 & 15, p = n & 63, im = n >> 6, j = 15 - sl; float v[8];
        const float ar = apr[j * 64 + p], ai = api[j * 64 + p];
#pragma unroll
        for (int i = 0; i < 8; ++i) { const float br = bbr[p * 16 + hp0 + i], bi = bbi[p * 16 + hp0 + i]; v[i] = im ? (ar * bi + ai * br) : (ar * br - ai * bi); }
        u32x4 o; o.x = pk2(v[0], v[1]); o.y = pk2(v[2], v[3]); o.z = pk2(v[4], v[5]); o.w = pk2(v[6], v[7]);
        *(u32x4*)(C.S5S_() + ((size_t)(g * 128 + n)) * 256 + k0) = o; }
    __syncthreads();
}

__device__ __forceinline__ void ph_prologue(const Ctx& C) {
    for (int g = C.wgid; g < NG; g += C.G) s5_tables(C, g);
    __syncthreads();
    LAS float* scr = (LAS float*)C.lds + C.wave * 2112;
    constexpr int I_QKV = 16 * 48, I_U = 16 * 16, I_GLU = 8 * 16, I_OUT = 16 * 32, I_GU1 = 16 * 16, I_D1 = 8 * 32;
    constexpr int NITEMS = I_QKV + I_U + I_GLU + I_OUT + NE * 2 * I_GU1 + NE * I_D1;
    for (int it = C.gw; it < NITEMS; it += C.NGW) {
        int r = it;
        if (r < I_QKV) { const int kb = r / 48, nb = r % 48; transpose_item(C.w_in_(), INC, C.Win_(), DM, 64 * kb, 32 * nb, 32 * nb, scr, C.lane); continue; } r -= I_QKV;
        if (r < I_U) { const int kb = r / 16, nb = r % 16; transpose_item(C.w_in_(), INC, C.Win_(), DM, 64 * kb, 1544 + 32 * nb, 1536 + 32 * nb, scr, C.lane); continue; } r -= I_U;
        if (r < I_GLU) { const int kb = r / 16, nb = r % 16; transpose_item(C.w_glu_(), SWD, C.Wglu_(), SWD, 64 * kb, 32 * nb, 32 * nb, scr, C.lane); continue; } r -= I_GLU;
        if (r < I_OUT) { const int kb = r / 32, nb = r % 32; transpose_item(C.w_out_(), DM, C.Wout_(), DM, 64 * kb, 32 * nb, 32 * nb, scr, C.lane); continue; } r -= I_OUT;
        if (r < NE * 2 * I_GU1) { const int e = r / (2 * I_GU1), r2 = r % (2 * I_GU1), up = r2 / I_GU1, r3 = r2 % I_GU1, kb = r3 / 16, nb = r3 % 16;
            const float* W = (up ? C.w_up_() : C.w_gate_()) + (size_t)e * DM * DE; const int n0 = 32 * nb; const int drow = 256 * (n0 >> 7) + 128 * up + (n0 & 127);
            transpose_item(W, DE, C.Wgu_() + (size_t)e * 1024 * 1024, DM, 64 * kb, n0, drow, scr, C.lane); continue; } r -= NE * 2 * I_GU1;
        { const int e = r / I_D1, r2 = r % I_D1, kb = r2 / 32, nb = r2 % 32;
            transpose_item(C.w_down_() + (size_t)e * DE * DM, DM, C.Wd_() + (size_t)e * DM * DE, DE, 64 * kb, 32 * nb, 32 * nb, scr, C.lane); }
    }
    float wf[4][4][8];
#pragma unroll
    for (int j = 0; j < 4; ++j)
#pragma unroll
        for (int i = 0; i < 4; ++i)
#pragma unroll
            for (int hh = 0; hh < 8; ++hh) wf[j][i][hh] = C.w_in_()[(size_t)(256 * j + 4 * C.lane + i) * INC + 1536 + hh];
    for (int row = C.gw; row < T; row += C.NGW) {
        const f32x4* xr = (const f32x4*)(C.x_() + (size_t)row * DM) + C.lane;
        f32x4 v[4]; float fl[8];
#pragma unroll
        for (int hh = 0; hh < 8; ++hh) fl[hh] = 0.f;
#pragma unroll
        for (int j = 0; j < 4; ++j) { v[j] = xr[64 * j];
#pragma unroll
            for (int i = 0; i < 4; ++i)
#pragma unroll
                for (int hh = 0; hh < 8; ++hh) fl[hh] += v[j][i] * wf[j][i][hh]; }
        u32x2* o8 = (u32x2*)(C.XB_() + (size_t)row * DM) + C.lane;
#pragma unroll
        for (int j = 0; j < 4; ++j) { u32x2 w; w.x = pk2(v[j][0], v[j][1]); w.y = pk2(v[j][2], v[j][3]); o8[64 * j] = w; }
#pragma unroll
        for (int hh = 0; hh < 8; ++hh) fl[hh] = wave_sum(fl[hh]);
        float mine = 0.f;
#pragma unroll
        for (int hh = 0; hh < 8; ++hh) mine = (C.lane == hh) ? fl[hh] : mine;
        if (C.lane < 8) { const float z = mine + C.b_fgate_()[C.lane]; const float ls = fminf(z, 0.f) - log1pf(__expf(-fabsf(z)));
            const int b = row / SEQ, t = row % SEQ; C.LOGF_()[((size_t)(b * NH + C.lane)) * SEQ + t] = ls; }
    }
}

__device__ __forceinline__ void ph_cumscan(const Ctx& C) {
    for (int s = C.gw; s < BATCH * NH; s += C.NGW) {
        const float* src = C.LOGF_() + (size_t)s * SEQ + 32 * C.lane; float v[32];
#pragma unroll
        for (int i = 0; i < 8; ++i) { const f32x4 t = *(const f32x4*)(src + 4 * i); v[4 * i] = t[0]; v[4 * i + 1] = t[1]; v[4 * i + 2] = t[2]; v[4 * i + 3] = t[3]; }
#pragma unroll
        for (int i = 1; i < 32; ++i) v[i] += v[i - 1];
        float tot = v[31], inc = tot;
#pragma unroll
        for (int o = 1; o < 64; o <<= 1) { const float t = __shfl_up(inc, o); if (C.lane >= o) inc += t; }
        const float off = inc - tot;
        float* dst = C.CUM_() + (size_t)s * SEQ + 32 * C.lane;
#pragma unroll
        for (int i = 0; i < 8; ++i) { f32x4 t; t[0] = (v[4 * i] + off) * LOG2E; t[1] = (v[4 * i + 1] + off) * LOG2E; t[2] = (v[4 * i + 2] + off) * LOG2E; t[3] = (v[4 * i + 3] + off) * LOG2E; *(f32x4*)(dst + 4 * i) = t; }
    }
}
__device__ __forceinline__ void ph_gemm1(const Ctx& C) {
    const int hi = C.lane >> 5, r32 = C.lane & 31;
    for (int id = C.gw; id < 512 * 32; id += C.NGW) {
        const int mb = id >> 5, nb = id & 31;
        const bf16_t* a0 = C.XB_() + (size_t)(mb * 64 + r32) * DM + 8 * hi; const bf16_t* b0 = C.Win_() + (size_t)(nb * 64 + r32) * DM + 8 * hi;
        f32x16 c00, c01, c10, c11; wave_gemm64(a0, a0 + 32 * DM, b0, b0 + 32 * DM, DM, c00, c01, c10, c11);
        FOR_ACC(c00, c01, c10, c11, {
            const int row = mb * 64 + rloc, col = nb * 64 + cloc;
            if (col < 512) C.Q_()[(size_t)row * AW + col] = (bf16_t)f2bf(val * C2);
            else if (col < 1024) C.K_()[(size_t)row * AW + col - 512] = (bf16_t)f2bf(val);
            else if (col < 1536) C.V_()[(size_t)row * AW + col - 1024] = (bf16_t)f2bf(val);
            else { const int cu = col - 1536, g = cu >> 4, h = cu & 15; C.UX_()[((size_t)(g * 2048 + (row >> 4))) * UXK + (row & 15) * 16 + h] = (bf16_t)f2bf(val); }
        });
    }
}

__device__ __forceinline__ void attn_wave_unit(const Ctx& C, int bh, int qb) {
    const int lane = C.lane, r32 = lane & 31, hi = lane >> 5, b = bh >> 3, hd = bh & 7;
    const size_t rowbase = (size_t)b * SEQ; const int q0 = qb * 32;
    const bf16_t* Qp = C.Q_() + (rowbase + q0 + r32) * AW + hd * 64 + 8 * hi;
    bf16x8 qr[4];
#pragma unroll
    for (int d0 = 0; d0 < 4; ++d0) qr[d0] = *(const bf16x8*)(Qp + 16 * d0);
    const float* cum = C.CUM_() + (size_t)bh * SEQ;
    const float cq = cum[q0 + r32];
    float m = -INFINITY, l = 0.f; f32x16 o0 = (f32x16){}, o1 = (f32x16){};
    for (int kt = 0; kt <= qb; ++kt) {
        const int kv0 = kt * 32;
        const bf16_t* Kp = C.K_() + (rowbase + kv0 + r32) * AW + hd * 64 + 8 * hi;
        f32x16 s = (f32x16){};
#pragma unroll
        for (int d0 = 0; d0 < 4; ++d0) { const bf16x8 kf = *(const bf16x8*)(Kp + 16 * d0); s = __builtin_amdgcn_mfma_f32_32x32x16_bf16(kf, qr[d0], s, 0, 0, 0); }
#pragma unroll
        for (int g = 0; g < 4; ++g) { const f32x4 ck = *(const f32x4*)(cum + kv0 + 8 * g + 4 * hi);
#pragma unroll
            for (int i = 0; i < 4; ++i) { const int r = 4 * g + i; float sv = s[r] + (cq - ck[i]); if (kt == qb && (8 * g + 4 * hi + i) > r32) sv = -INFINITY; s[r] = sv; } }
        float mx = s[0];
#pragma unroll
        for (int r = 1; r < 16; ++r) mx = fmaxf(mx, s[r]);
        mx = fmaxf(mx, __shfl_xor(mx, 32));
        const float mn = fmaxf(m, mx), alpha = __builtin_amdgcn_exp2f(m - mn); m = mn;
        float psum = 0.f;
#pragma unroll
        for (int r = 0; r < 16; ++r) { s[r] = __builtin_amdgcn_exp2f(s[r] - mn); psum += s[r]; }
        l = l * alpha + psum;
#pragma unroll
        for (int r = 0; r < 16; ++r) { const float ar = __shfl(alpha, crow(r, hi)); o0[r] *= ar; o1[r] *= ar; }
        bf16x8 pa0, pa1;
#pragma unroll
        for (int j = 0; j < 8; ++j) { pa0[j] = (short)f2bf(s[j]); pa1[j] = (short)f2bf(s[8 + j]); }
        const bf16_t* Vp = C.V_() + (rowbase + kv0) * AW + hd * 64 + r32;
#pragma unroll
        for (int sidx = 0; sidx < 2; ++sidx) {
            bf16x8 vf0, vf1;
#pragma unroll
            for (int j = 0; j < 8; ++j) { const int kvl = 16 * sidx + 8 * (j >> 2) + 4 * hi + (j & 3); vf0[j] = (short)Vp[(size_t)kvl * AW]; vf1[j] = (short)Vp[(size_t)kvl * AW + 32]; }
            o0 = __builtin_amdgcn_mfma_f32_32x32x16_bf16(sidx ? pa1 : pa0, vf0, o0, 0, 0, 0);
            o1 = __builtin_amdgcn_mfma_f32_32x32x16_bf16(sidx ? pa1 : pa0, vf1, o1, 0, 0, 0);
        }
    }
    const float ltot = l + __shfl_xor(l, 32), inv = 1.0f / ltot;
#pragma unroll
    for (int r = 0; r < 16; ++r) { const float ir = __shfl(inv, crow(r, hi)); const size_t row = rowbase + q0 + crow(r, hi);
        C.YCAT_()[row * DM + hd * 64 + r32] = (bf16_t)f2bf(o0[r] * ir); C.YCAT_()[row * DM + hd * 64 + 32 + r32] = (bf16_t)f2bf(o1[r] * ir); }
}
__device__ __forceinline__ void ph_attention(const Ctx& C) {
    for (int u = C.gw; u < 128 * 64; u += C.NGW) { const int qb = 63 - (u >> 7), bh = u & 127; attn_wave_unit(C, bh, qb); }
}
__device__ __forceinline__ void ph_s5a(const Ctx& C) {
    const int hi = C.lane >> 5, r32 = C.lane & 31;
    for (int id = C.gw; id < 2048; id += C.NGW) {
        const int g = id >> 6, mb = (id >> 1) & 31, nb = id & 1;
        const bf16_t* a0 = C.UX_() + (size_t)(g * 2048 + mb * 64 + r32) * UXK + 8 * hi; const bf16_t* b0 = C.S5S_() + (size_t)(g * 128 + nb * 64 + r32) * 256 + 8 * hi;
        f32x16 c00, c01, c10, c11; wave_gemm64(a0, a0 + 32 * UXK, b0, b0 + 32 * 256, 256, c00, c01, c10, c11);
        FOR_ACC(c00, c01, c10, c11, { C.SLOC_()[(size_t)(g * 2048 + mb * 64 + rloc) * 128 + nb * 64 + cloc] = val; });
    }
}
__device__ __forceinline__ void ph_s5b(const Ctx& C) {
    for (int idx = C.wgid * 512 + C.tid; idx < NG * BATCH * SP; idx += C.G * 512) {
        const int g = idx >> 10, b = (idx >> 6) & 15, p = idx & 63;
        const float ar = C.S5A_()[(g * 64 + p) * 2], ai = C.S5A_()[(g * 64 + p) * 2 + 1];
        float xr = 0.f, xi = 0.f;
        for (int c = 0; c < NCH; ++c) { const size_t row = (size_t)g * 2048 + b * 128 + c;
            C.UX_()[row * UXK + 256 + p] = (bf16_t)f2bf(xr); C.UX_()[row * UXK + 320 + p] = (bf16_t)f2bf(xi);
            const float sr = C.SLOC_()[row * 128 + p], si = C.SLOC_()[row * 128 + 64 + p];
            const float nr = ar * xr - ai * xi + sr, ni = ar * xi + ai * xr + si; xr = nr; xi = ni; }
    }
}
__device__ __forceinline__ void ph_s5c(const Ctx& C) {
    const int hi = C.lane >> 5, r32 = C.lane & 31;
    for (int id = C.gw; id < 4096; id += C.NGW) {
        const int g = id >> 7, mb = (id >> 2) & 31, nb = id & 3;
        const bf16_t* a0 = C.UX_() + (size_t)(g * 2048 + mb * 64 + r32) * UXK + 8 * hi; const bf16_t* b0 = C.S5W_() + (size_t)(g * 256 + nb * 64 + r32) * UXK + 8 * hi;
        f32x16 c00, c01, c10, c11; wave_gemm64(a0, a0 + 32 * UXK, b0, b0 + 32 * UXK, UXK, c00, c01, c10, c11);
        FOR_ACC(c00, c01, c10, c11, {
            const int row = mb * 64 + rloc, n = nb * 64 + cloc, tl = n >> 4, h = n & 15;
            const float u = bf2f(C.UX_()[(size_t)(g * 2048 + row) * UXK + n]);
            const float yv = val + C.dskip_()[g * 16 + h] * u;
            C.Y_()[((size_t)row * 16 + tl) * SWD + g * 16 + h] = (bf16_t)f2bf(gelu_tanh(yv));
        });
    }
}
__device__ __forceinline__ void ph_glu(const Ctx& C) {
    const int hi = C.lane >> 5, r32 = C.lane & 31;
    for (int id = C.gw; id < 512 * 8; id += C.NGW) {
        const int mb = id >> 3, nb = id & 7;
        const bf16_t* a0 = C.Y_() + (size_t)(mb * 64 + r32) * SWD + 8 * hi; const bf16_t* b0 = C.Wglu_() + (size_t)(nb * 64 + r32) * SWD + 8 * hi;
        f32x16 c00, c01, c10, c11; wave_gemm64(a0, a0 + 32 * SWD, b0, b0 + 32 * SWD, SWD, c00, c01, c10, c11);
        FOR_ACC(c00, c01, c10, c11, {
            const int row = mb * 64 + rloc, col = nb * 64 + cloc;
            const float yv = bf2f(C.Y_()[(size_t)row * SWD + col]);
            C.YCAT_()[(size_t)row * DM + 512 + col] = (bf16_t)f2bf(yv * sigmoidf_(val + C.b_glu_()[col]));
        });
    }
}
__device__ __forceinline__ void ph_norm(const Ctx& C) {
    for (int row = C.gw; row < T; row += C.NGW) {
        bf16_t* p = C.YCAT_() + (size_t)row * DM + 16 * C.lane;
        const u32x4 w0 = *(const u32x4*)p, w1 = *(const u32x4*)(p + 8); float v[16];
#pragma unroll
        for (int i = 0; i < 4; ++i) { v[2 * i] = bf2f((unsigned short)(w0[i] & 0xffff)); v[2 * i + 1] = bf2f((unsigned short)(w0[i] >> 16)); v[8 + 2 * i] = bf2f((unsigned short)(w1[i] & 0xffff)); v[8 + 2 * i + 1] = bf2f((unsigned short)(w1[i] >> 16)); }
        float ss = 0.f;
#pragma unroll
        for (int i = 0; i < 16; ++i) ss += v[i] * v[i];
#pragma unroll
        for (int o = 1; o < 32; o <<= 1) ss += __shfl_xor(ss, o);
        const float sc = 1.0f / sqrtf(ss * (1.0f / 512.0f) + RMS_EPS);
        const float* gp = (C.lane < 32) ? (C.attn_g_() + 16 * C.lane) : (C.ssm_g_() + 16 * (C.lane - 32));
#pragma unroll
        for (int i = 0; i < 16; ++i) v[i] = v[i] * sc * gp[i];
        u32x4 o0, o1;
#pragma unroll
        for (int i = 0; i < 4; ++i) { o0[i] = pk2(v[2 * i], v[2 * i + 1]); o1[i] = pk2(v[8 + 2 * i], v[8 + 2 * i + 1]); }
        *(u32x4*)p = o0; *(u32x4*)(p + 8) = o1;
    }
}
__device__ __forceinline__ void ph_wout(const Ctx& C) {
    const int hi = C.lane >> 5, r32 = C.lane & 31;
    for (int id = C.gw; id < 512 * 16; id += C.NGW) {
        const int mb = id >> 4, nb = id & 15;
        const bf16_t* a0 = C.YCAT_() + (size_t)(mb * 64 + r32) * DM + 8 * hi; const bf16_t* b0 = C.Wout_() + (size_t)(nb * 64 + r32) * DM + 8 * hi;
        f32x16 c00, c01, c10, c11; wave_gemm64(a0, a0 + 32 * DM, b0, b0 + 32 * DM, DM, c00, c01, c10, c11);
        FOR_ACC(c00, c01, c10, c11, { C.out_()[(size_t)(mb * 64 + rloc) * DM + nb * 64 + cloc] = val; });
    }
}
__device__ __forceinline__ void ph_ln1(const Ctx& C) {
    for (int row = C.gw; row < T; row += C.NGW) {
        const f32x4* xr = (const f32x4*)(C.x_() + (size_t)row * DM) + C.lane; f32x4* mr = (f32x4*)(C.out_() + (size_t)row * DM) + C.lane;
        f32x4 v[4]; float s = 0.f;
#pragma unroll
        for (int j = 0; j < 4; ++j) { v[j] = xr[64 * j] * ALPHA + mr[64 * j]; s += (v[j][0] + v[j][1]) + (v[j][2] + v[j][3]); }
        const float mean = wave_sum(s) * (1.0f / DM); float q = 0.f;
#pragma unroll
        for (int j = 0; j < 4; ++j) { v[j] = v[j] - mean; q += (v[j][0] * v[j][0] + v[j][1] * v[j][1]) + (v[j][2] * v[j][2] + v[j][3] * v[j][3]); }
        const float rstd = 1.0f / sqrtf(wave_sum(q) * (1.0f / DM) + LN_EPS);
        u32x2* hb = (u32x2*)(C.HB_() + (size_t)row * DM) + C.lane;
#pragma unroll
        for (int j = 0; j < 4; ++j) { const f32x4 g = *((const f32x4*)C.ln1_g_() + C.lane + 64 * j), bb = *((const f32x4*)C.ln1_b_() + C.lane + 64 * j);
            const f32x4 o = v[j] * rstd * g + bb; mr[64 * j] = o; u32x2 w; w.x = pk2(o[0], o[1]); w.y = pk2(o[2], o[3]); hb[64 * j] = w; }
    }
}
__device__ __forceinline__ void ph_router(const Ctx& C) {
    for (int tok = C.gw; tok < T; tok += C.NGW) {
        const f32x4* hr = (const f32x4*)(C.out_() + (size_t)tok * DM) + C.lane;
        float acc[36];
#pragma unroll
        for (int i = 0; i < 36; ++i) acc[i] = 0.f;
#pragma unroll
        for (int j = 0; j < 4; ++j) { const f32x4 hv = hr[64 * j];
#pragma unroll
            for (int i = 0; i < 4; ++i) { const int k = 256 * j + 4 * C.lane + i; const float hx = hv[i];
                const f32x4 wg = *(const f32x4*)(C.w_rg_() + (size_t)k * 4);
#pragma unroll
                for (int c = 0; c < 4; ++c) acc[c] += hx * wg[c];
#pragma unroll
                for (int c4 = 0; c4 < 8; ++c4) { const f32x4 we = *(const f32x4*)(C.w_re_() + (size_t)k * 32 + 4 * c4);
#pragma unroll
                    for (int c = 0; c < 4; ++c) acc[4 + 4 * c4 + c] += hx * we[c]; } } }
#pragma unroll
        for (int i = 0; i < 36; ++i) acc[i] = wave_sum(acc[i]);
#pragma unroll
        for (int c = 0; c < 4; ++c) acc[c] += C.b_rg_()[c];
#pragma unroll
        for (int c = 0; c < 32; ++c) acc[4 + c] += C.b_re2_()[c];
        int gi = 0; float gm = acc[0];
#pragma unroll
        for (int c = 1; c < 4; ++c) if (acc[c] > gm) { gm = acc[c]; gi = c; }
        float gs = 0.f;
#pragma unroll
        for (int c = 0; c < 4; ++c) gs += __expf(acc[c] - gm);
        const float gp = 1.0f / gs;
        float el[8];
#pragma unroll
        for (int i = 0; i < 8; ++i) el[i] = (gi == 0) ? acc[4 + i] : (gi == 1) ? acc[12 + i] : (gi == 2) ? acc[20 + i] : acc[28 + i];
        int i1 = 0; float l1 = el[0];
#pragma unroll
        for (int i = 1; i < 8; ++i) if (el[i] > l1) { l1 = el[i]; i1 = i; }
        int i2 = -1; float l2 = -INFINITY;
#pragma unroll
        for (int i = 0; i < 8; ++i) if (i != i1 && el[i] > l2) { l2 = el[i]; i2 = i; }
        const float p1 = 1.0f / (1.0f + __expf(l2 - l1)), p2 = 1.0f - p1;
        if (C.lane == 0) {
            const int e1 = gi * 8 + i1, e2 = gi * 8 + i2;
            const unsigned pos1 = atomicAdd(C.ctl_() + CW_CNT + e1, 1u); C.LIST_()[(size_t)e1 * T + pos1] = 2 * tok; C.GATE_()[2 * tok] = gp * p1;
            const unsigned pos2 = atomicAdd(C.ctl_() + CW_CNT + e2, 1u); C.LIST_()[(size_t)e2 * T + pos2] = 2 * tok + 1; C.GATE_()[2 * tok + 1] = gp * p2;
        }
    }
}
struct MoeMap { int cnt, incl, excl, offc, total; };
__device__ __forceinline__ MoeMap moe_map(const Ctx& C, int tiles_per_mb) {
    MoeMap M; const int lane = C.lane;
    const int c = (lane < 32) ? (int)__hip_atomic_load(C.ctl_() + CW_CNT + lane, __ATOMIC_RELAXED, __HIP_MEMORY_SCOPE_AGENT) : 0;
    const int tl = ((c + 63) >> 6) * tiles_per_mb;
    int inc = tl, incc = c;
#pragma unroll
    for (int o = 1; o < 32; o <<= 1) { const int t1 = __shfl_up(inc, o), t2 = __shfl_up(incc, o); if ((lane & 31) >= o) { inc += t1; incc += t2; } }
    M.cnt = c; M.incl = (lane < 32) ? inc : 0x7fffffff; M.excl = inc - tl; M.offc = incc - c; M.total = __shfl(inc, 31);
    return M;
}
__device__ __forceinline__ void ph_moe_up(const Ctx& C) {
    const int lane = C.lane, hi = lane >> 5, r32 = lane & 31;
    const MoeMap M = moe_map(C, 16);
    for (int id = C.gw; id < M.total; id += C.NGW) {
        const int e = __popcll(__ballot(lane < 32 && M.incl <= id));
        const int base = id - __shfl(M.excl, e), mb = base >> 4, nb = base & 15, ce = __shfl(M.cnt, e), offe = __shfl(M.offc, e);
        const int s0 = mb * 64 + r32, s1 = s0 + 32;
        const int t0 = (s0 < ce) ? (C.LIST_()[(size_t)e * T + s0] >> 1) : 0, t1 = (s1 < ce) ? (C.LIST_()[(size_t)e * T + s1] >> 1) : 0;
        const bf16_t* a0 = C.HB_() + (size_t)t0 * DM + 8 * hi; const bf16_t* a1 = C.HB_() + (size_t)t1 * DM + 8 * hi;
        const bf16_t* b0 = C.Wgu_() + ((size_t)e * 1024 + (nb >> 2) * 256 + (nb & 3) * 32 + r32) * DM + 8 * hi;
        f32x16 c00, c01, c10, c11; wave_gemm64(a0, a1, b0, b0 + 128 * DM, DM, c00, c01, c10, c11);
#pragma unroll
        for (int r = 0; r < 16; ++r) { const int rl = crow(r, hi);
            { const int slot = mb * 64 + rl; if (slot < ce) { const float g = c00[r], u = c01[r]; C.HID_()[(size_t)(offe + slot) * DE + nb * 32 + r32] = (bf16_t)f2bf(g * sigmoidf_(g) * u); } }
            { const int slot = mb * 64 + 32 + rl; if (slot < ce) { const float g = c10[r], u = c11[r]; C.HID_()[(size_t)(offe + slot) * DE + nb * 32 + r32] = (bf16_t)f2bf(g * sigmoidf_(g) * u); } } }
    }
}
__device__ __forceinline__ void ph_moe_down(const Ctx& C) {
    const int lane = C.lane, hi = lane >> 5, r32 = lane & 31;
    const MoeMap M = moe_map(C, 16);
    for (int id = C.gw; id < M.total; id += C.NGW) {
        const int e = __popcll(__ballot(lane < 32 && M.incl <= id));
        const int base = id - __shfl(M.excl, e), mb = base >> 4, nb = base & 15, ce = __shfl(M.cnt, e), offe = __shfl(M.offc, e);
        const bf16_t* a0 = C.HID_() + (size_t)(offe + mb * 64 + r32) * DE + 8 * hi;
        const bf16_t* b0 = C.Wd_() + ((size_t)e * 1024 + nb * 64 + r32) * DE + 8 * hi;
        f32x16 c00, c01, c10, c11; wave_gemm64(a0, a0 + 32 * DE, b0, b0 + 32 * DE, DE, c00, c01, c10, c11);
        FOR_ACC(c00, c01, c10, c11, {
            const int slot = mb * 64 + rloc;
            if (slot < ce) { const int a = C.LIST_()[(size_t)e * T + slot]; const float gt = C.GATE_()[a]; C.YASG_()[(size_t)a * DM + nb * 64 + cloc] = (bf16_t)f2bf(gt * val); }
        });
    }
}
__device__ __forceinline__ void ph_final(const Ctx& C) {
    for (int row = C.gw; row < T; row += C.NGW) {
        f32x4* hr = (f32x4*)(C.out_() + (size_t)row * DM) + C.lane;
        const u32x2* ya = (const u32x2*)(C.YASG_() + (size_t)(2 * row) * DM) + C.lane; const u32x2* yb = (const u32x2*)(C.YASG_() + (size_t)(2 * row + 1) * DM) + C.lane;
        f32x4 v[4]; float s = 0.f;
#pragma unroll
        for (int j = 0; j < 4; ++j) { const u32x2 a = ya[64 * j], b = yb[64 * j];
            f32x4 m; m[0] = bf2f((unsigned short)(a.x & 0xffff)) + bf2f((unsigned short)(b.x & 0xffff)); m[1] = bf2f((unsigned short)(a.x >> 16)) + bf2f((unsigned short)(b.x >> 16));
            m[2] = bf2f((unsigned short)(a.y & 0xffff)) + bf2f((unsigned short)(b.y & 0xffff)); m[3] = bf2f((unsigned short)(a.y >> 16)) + bf2f((unsigned short)(b.y >> 16));
            v[j] = hr[64 * j] * ALPHA + m; s += (v[j][0] + v[j][1]) + (v[j][2] + v[j][3]); }
        const float mean = wave_sum(s) * (1.0f / DM); float q = 0.f;
#pragma unroll
        for (int j = 0; j < 4; ++j) { v[j] = v[j] - mean; q += (v[j][0] * v[j][0] + v[j][1] * v[j][1]) + (v[j][2] * v[j][2] + v[j][3] * v[j][3]); }
        const float rstd = 1.0f / sqrtf(wave_sum(q) * (1.0f / DM) + LN_EPS);
#pragma unroll
        for (int j = 0; j < 4; ++j) { const f32x4 g = *((const f32x4*)C.ln2_g_() + C.lane + 64 * j), bb = *((const f32x4*)C.ln2_b_() + C.lane + 64 * j); hr[64 * j] = v[j] * rstd * g + bb; }
    }
}

constexpr int NPHASE = 13;
constexpr int LDS_BYTES = 147456;

#define XB_TMO      128
#define XB_XCNT(j)  (256  + 64 * (j))
#define XB_XSUB(j)  (1280 + 64 * (j))
#define XB_XGEN(j)  (2304 + 64 * (j))
#define XB_TOP      3328
#define XB_TOPGEN   3392
#define XCD_BAR_WORDS 3456
#define XB_SPIN_CAP (1u << 18)
constexpr int CW_BAR = 4096;
__device__ __forceinline__ unsigned xb_ld(unsigned* p)              { return __hip_atomic_load(p, __ATOMIC_RELAXED, __HIP_MEMORY_SCOPE_AGENT); }
__device__ __forceinline__ unsigned xb_add(unsigned* p, unsigned v) { return __hip_atomic_fetch_add(p, v, __ATOMIC_RELAXED, __HIP_MEMORY_SCOPE_AGENT); }
__device__ __forceinline__ unsigned xb_xcc_id() { return (unsigned)__builtin_amdgcn_s_getreg((3 << 11) | 20) & 0xFu; }
#define XB_SPIN(cond, bar) do { unsigned _sp = 0; while (cond) { __builtin_amdgcn_s_sleep(1); \
    if ((++_sp & 255u) == 0u) { if (xb_ld(&(bar)[XB_TMO])) break; if (_sp > XB_SPIN_CAP) { atomicAdd(&(bar)[XB_TMO], 1u); break; } } } } while (0)
struct XcdBarrier { unsigned* bar; unsigned x; volatile LAS unsigned* st; };
__device__ __forceinline__ XcdBarrier xcd_barrier_post(unsigned* bar, volatile LAS unsigned* st) {
    XcdBarrier b; b.bar = bar; b.x = xb_xcc_id(); b.st = st;
    if (threadIdx.x == 0) (void)xb_add(&bar[XB_XCNT(b.x)], 1u);
    return b;
}
__device__ __forceinline__ void xcd_barrier_complete(unsigned* bar, unsigned x, unsigned& nloc, unsigned& nx) {
    const unsigned G = gridDim.x * gridDim.y * gridDim.z;
    unsigned sum, cnt, mine, sp = 0u;
    for (;;) {
        sum = 0u; cnt = 0u; mine = 0u;
#pragma unroll
        for (unsigned j = 0; j < 16; ++j) { const unsigned c = xb_ld(&bar[XB_XCNT(j)]); sum += c; cnt += (c > 0u) ? 1u : 0u; mine = (j == x) ? c : mine; }
        if (sum == G) break;
        __builtin_amdgcn_s_sleep(1);
        if ((++sp & 255u) == 0u) { if (xb_ld(&bar[XB_TMO])) break; if (sp > XB_SPIN_CAP) { atomicAdd(&bar[XB_TMO], 1u); break; } }
    }
    nloc = mine > 0u ? mine : 1u; nx = cnt > 0u ? cnt : 1u;
}
__device__ __forceinline__ void xcd_barrier(const XcdBarrier& b) {
    asm volatile("s_waitcnt vmcnt(0)" ::: "memory");
    __syncthreads();
    if (threadIdx.x == 0) {
        unsigned* bar = b.bar;
        __builtin_amdgcn_s_waitcnt(0);
        unsigned nloc = b.st[0], nx = b.st[1];
        if (nloc == 0u) { xcd_barrier_complete(bar, b.x, nloc, nx); b.st[0] = nloc; b.st[1] = nx; }
        const unsigned old = xb_add(&bar[XB_XSUB(b.x)], 1u);
        const unsigned gen = old / nloc;
        if (old + 1u == (gen + 1u) * nloc) {
            __builtin_amdgcn_fence(__ATOMIC_RELEASE, "agent");
            asm volatile("s_waitcnt vmcnt(0)" ::: "memory");
            const unsigned og = xb_add(&bar[XB_TOP], 1u);
            const unsigned tg = og / nx;
            if (og + 1u == (tg + 1u) * nx) xb_add(&bar[XB_TOPGEN], 1u);
            else XB_SPIN(xb_ld(&bar[XB_TOPGEN]) == tg, bar);
            __builtin_amdgcn_fence(__ATOMIC_ACQUIRE, "agent");
            xb_add(&bar[XB_XGEN(b.x)], 1u);
            asm volatile("s_waitcnt vmcnt(0)" ::: "memory");
        } else {
            XB_SPIN(xb_ld(&bar[XB_XGEN(b.x)]) == gen, bar);
            __builtin_amdgcn_fence(__ATOMIC_ACQUIRE, "agent");
            asm volatile("s_waitcnt vmcnt(0)" ::: "memory");
        }
    }
    __syncthreads();
}

constexpr int MISC_OFF = 147456 - 128;
__global__ void __launch_bounds__(512, 2) fwd_kernel(Args args) {
    extern __shared__ __attribute__((aligned(16))) unsigned char lds[];
    Ctx C;
    C.tid = threadIdx.x; C.lane = C.tid & 63; C.wave = __builtin_amdgcn_readfirstlane(C.tid >> 6); C.wgid = blockIdx.x; C.G = gridDim.x;
    C.gw = C.wgid * 8 + C.wave; C.NGW = C.G * 8; C.lds = (LAS unsigned char*)lds;
    C.a = &args;
    volatile LAS unsigned* MISC = (volatile LAS unsigned*)(C.lds + MISC_OFF);
    if (C.tid < 32) MISC[C.tid] = 0u;
    __syncthreads();
    XcdBarrier bar = xcd_barrier_post((unsigned*)(args.ws + WS_CTL) + CW_BAR, MISC + 8);
    const int lo = args.ph_lo, hi = args.ph_hi;
#define IN(k) (lo <= (k) && (k) < hi)
#define SEAM(k) do { if (IN(k) && IN((k) + 1)) xcd_barrier(bar); asm volatile("" : "+v"(C.lane), "+v"(C.tid)); asm volatile("" : "+s"(C.gw), "+s"(C.NGW), "+s"(C.wgid), "+s"(C.G)); } while (0)
    if (IN(0)) ph_prologue(C); SEAM(0);
    if (IN(1)) { ph_cumscan(C); ph_gemm1(C); } SEAM(1);
    if (IN(2)) { ph_attention(C); ph_s5a(C); } SEAM(2);
    if (IN(3)) ph_s5b(C); SEAM(3);
    if (IN(4)) ph_s5c(C); SEAM(4);
    if (IN(5)) ph_glu(C); SEAM(5);
    if (IN(6)) ph_norm(C); SEAM(6);
    if (IN(7)) ph_wout(C); SEAM(7);
    if (IN(8)) ph_ln1(C); SEAM(8);
    if (IN(9)) ph_router(C); SEAM(9);
    if (IN(10)) ph_moe_up(C); SEAM(10);
    if (IN(11)) ph_moe_down(C); SEAM(11);
    if (IN(12)) ph_final(C);
#undef IN
#undef SEAM
}

extern "C" void kernel_launch(void* const* d_in, const int* in_sizes, int n_in, void* d_out, int out_size, void* d_ws, size_t ws_size, hipStream_t stream) {
    static int grid = 0;
    if (grid == 0) {
        if (n_in != 27 || in_sizes[0] != T * DM || out_size != T * DM || ws_size < WS_END) {
            fprintf(stderr, "kernel_launch: unexpected shapes: n_in %d in0 %d out %d ws %zu\n", n_in, n_in > 0 ? in_sizes[0] : -1, out_size, ws_size); grid = -1; return; }
        int dev = 0, cus = 0;
        if (hipGetDevice(&dev) != hipSuccess || hipDeviceGetAttribute(&cus, hipDeviceAttributeMultiprocessorCount, dev) != hipSuccess) { grid = -1; return; }
        if (hipFuncSetAttribute((const void*)fwd_kernel, hipFuncAttributeMaxDynamicSharedMemorySize, LDS_BYTES) != hipSuccess) { fprintf(stderr, "kernel_launch: hipFuncSetAttribute failed\n"); grid = -1; return; }
        grid = cus > 0 ? cus : 256;
    }
    if (grid < 0) return;
    (void)hipMemsetAsync((char*)d_ws + WS_CTL, 0, CTL_BYTES, stream);
    Args a{};
    for (int i = 0; i < 27; ++i) a.in[i] = (const float*)d_in[i];
    a.out = (float*)d_out; a.ws = (unsigned char*)d_ws;
    a.ph_lo = 0; a.ph_hi = NPHASE;
    hipLaunchKernelGGL(fwd_kernel, dim3(grid), dim3(512), LDS_BYTES, stream, a);
}
```

```cpp
#include <hip/hip_runtime.h>
#include <hip/hip_bf16.h>
#include <cmath>
#include <cstdint>
#include <cstdio>

#define LAS __attribute__((address_space(3)))
typedef unsigned short bf16_t;
typedef short bf16x8 __attribute__((ext_vector_type(8)));
typedef float f32x4 __attribute__((ext_vector_type(4)));
typedef float f32x16 __attribute__((ext_vector_type(16)));
typedef unsigned u32x4 __attribute__((ext_vector_type(4)));
typedef unsigned u32x2 __attribute__((ext_vector_type(2)));

constexpr int BATCH = 16, SEQ = 2048, T = BATCH * SEQ, DM = 1024;
constexpr int AW = 512, NH = 8, HD = 64, SWD = 512, SGC = 16, NG = 32, SP = 64, INC = 2056;
constexpr int NE = 32, DE = 512;
constexpr int TC = 16, NCH = SEQ / TC, UXK = 384;
constexpr float ALPHA = 1.189207115002721f;
constexpr float LN_EPS = 1e-5f, RMS_EPS = 1e-6f;
constexpr float LOG2E = 1.4426950408889634f;
constexpr float C2 = 0.125f * LOG2E;

constexpr size_t MiB = 1u << 20;
constexpr size_t WS_CTL = 0, CTL_BYTES = 1 * MiB;
constexpr size_t WS_WIN = 2 * MiB;
constexpr size_t WS_WGLU = 6 * MiB;
constexpr size_t WS_WOUT = 7 * MiB;
constexpr size_t WS_S5S = 9 * MiB;
constexpr size_t WS_S5W = 13 * MiB;
constexpr size_t WS_S5A = 19 * MiB;
constexpr size_t WS_WR = 19 * MiB + 65536;
constexpr size_t WS_WGU = 20 * MiB;
constexpr size_t WS_WD = 84 * MiB;
constexpr size_t WS_XB = 116 * MiB;
constexpr size_t WS_HID = WS_XB;
constexpr size_t WS_Q = 181 * MiB, WS_K = 213 * MiB, WS_V = 245 * MiB;
constexpr size_t WS_UX = 277 * MiB;
constexpr size_t WS_YASG = 181 * MiB;
constexpr size_t WS_YCAT = 325 * MiB;
constexpr size_t WS_Y = 389 * MiB;
constexpr size_t WS_HB = 421 * MiB;
constexpr size_t WS_SLOC = WS_HB;
constexpr size_t WS_CUM = 485 * MiB;
constexpr size_t WS_LOGF = 486 * MiB;
constexpr size_t WS_GATE = 487 * MiB;
constexpr size_t WS_LIST = 488 * MiB;
constexpr size_t WS_END = 512 * MiB;
constexpr int CW_CNT = 1024;

struct Args { const float* in[27]; float* out; unsigned char* ws; int ph_lo, ph_hi, G, pad; };

struct Ctx {
    int tid, lane, wave, wgid, G, gw, NGW;
    LAS unsigned char* lds;
    const Args* a;
#define GAS __attribute__((address_space(1)))
#define CIN(name, idx) __device__ __forceinline__ const float* name() const { GAS const float* p_ = (GAS const float*)a->in[idx]; asm volatile("" : "+s"(p_)); return (const float*)p_; }
    CIN(x_, 0) CIN(w_in_, 1) CIN(b_fgate_, 2) CIN(lam_re_, 3) CIN(lam_im_, 4) CIN(log_step_, 5) CIN(b_re_, 6) CIN(b_im_, 7) CIN(c_re_, 8) CIN(c_im_, 9) CIN(dskip_, 10)
    CIN(w_glu_, 11) CIN(b_glu_, 12) CIN(attn_g_, 13) CIN(ssm_g_, 14) CIN(w_out_, 15) CIN(ln1_g_, 16) CIN(ln1_b_, 17) CIN(w_rg_, 18) CIN(b_rg_, 19) CIN(w_re_, 20) CIN(b_re2_, 21)
    CIN(w_gate_, 22) CIN(w_up_, 23) CIN(w_down_, 24) CIN(ln2_g_, 25) CIN(ln2_b_, 26)
#undef CIN
#define CWS(type, name, off) __device__ __forceinline__ type* name() const { GAS unsigned char* p_ = (GAS unsigned char*)a->ws; asm volatile("" : "+s"(p_)); return (type*)(unsigned char*)(p_ + (off)); }
    CWS(unsigned, ctl_, WS_CTL) CWS(bf16_t, Win_, WS_WIN) CWS(bf16_t, Wglu_, WS_WGLU) CWS(bf16_t, Wout_, WS_WOUT) CWS(bf16_t, S5S_, WS_S5S) CWS(bf16_t, S5W_, WS_S5W)
    CWS(bf16_t, Wgu_, WS_WGU) CWS(bf16_t, Wd_, WS_WD) CWS(bf16_t, XB_, WS_XB) CWS(bf16_t, HID_, WS_HID) CWS(bf16_t, Q_, WS_Q) CWS(bf16_t, K_, WS_K) CWS(bf16_t, V_, WS_V)
    CWS(bf16_t, UX_, WS_UX) CWS(bf16_t, YASG_, WS_YASG) CWS(bf16_t, YCAT_, WS_YCAT) CWS(bf16_t, Y_, WS_Y) CWS(bf16_t, HB_, WS_HB)
    CWS(float, S5A_, WS_S5A) CWS(bf16_t, WR_, WS_WR) CWS(float, SLOC_, WS_SLOC) CWS(float, CUM_, WS_CUM) CWS(float, LOGF_, WS_LOGF) CWS(float, GATE_, WS_GATE) CWS(int, LIST_, WS_LIST)
#undef CWS
    __device__ __forceinline__ float* out_() const { GAS float* p_ = (GAS float*)a->out; asm volatile("" : "+s"(p_)); return (float*)p_; }
};

__device__ __forceinline__ int lane_id_v() { int l; asm volatile("v_mbcnt_lo_u32_b32 %0, -1, 0\n\tv_mbcnt_hi_u32_b32 %0, -1, %0" : "=v"(l)); return l & 63; }
__device__ __forceinline__ unsigned f2bf(float f) { unsigned u = __builtin_bit_cast(unsigned, f); return (u + 0x7fffu + ((u >> 16) & 1u)) >> 16; }
__device__ __forceinline__ float bf2f(unsigned short b) { return __builtin_bit_cast(float, (unsigned)b << 16); }
__device__ __forceinline__ unsigned pk2(float lo, float hi) { return f2bf(lo) | (f2bf(hi) << 16); }
__device__ __forceinline__ float wave_sum(float v) {
#pragma unroll
    for (int o = 1; o < 64; o <<= 1) v += __shfl_xor(v, o);
    return v;
}
__device__ __forceinline__ int crow(int r, int hi) { return (r & 3) + 8 * (r >> 2) + 4 * hi; }
__device__ __forceinline__ float sigmoidf_(float s) { return 1.0f / (1.0f + __expf(-s)); }
__device__ __forceinline__ float gelu_tanh(float v) { const float z = 0.7978845608028654f * (v + 0.044715f * v * v * v); const float t = 1.0f - 2.0f / (__expf(2.0f * z) + 1.0f); return 0.5f * v * (1.0f + t); }

__device__ __forceinline__ void wave_gemm64(const bf16_t* a0, const bf16_t* a1, const bf16_t* b0, const bf16_t* b1, int K,
                                            f32x16& c00, f32x16& c01, f32x16& c10, f32x16& c11) {
    c00 = (f32x16){}; c01 = (f32x16){}; c10 = (f32x16){}; c11 = (f32x16){};
    for (int k = 0; k < K; k += 32) {
        const bf16x8 A0 = *(const bf16x8*)(a0 + k), A1 = *(const bf16x8*)(a1 + k), B0 = *(const bf16x8*)(b0 + k), B1 = *(const bf16x8*)(b1 + k);
        const bf16x8 A0b = *(const bf16x8*)(a0 + k + 16), A1b = *(const bf16x8*)(a1 + k + 16), B0b = *(const bf16x8*)(b0 + k + 16), B1b = *(const bf16x8*)(b1 + k + 16);
        c00 = __builtin_amdgcn_mfma_f32_32x32x16_bf16(A0, B0, c00, 0, 0, 0);
        c01 = __builtin_amdgcn_mfma_f32_32x32x16_bf16(A0, B1, c01, 0, 0, 0);
        c10 = __builtin_amdgcn_mfma_f32_32x32x16_bf16(A1, B0, c10, 0, 0, 0);
        c11 = __builtin_amdgcn_mfma_f32_32x32x16_bf16(A1, B1, c11, 0, 0, 0);
        c00 = __builtin_amdgcn_mfma_f32_32x32x16_bf16(A0b, B0b, c00, 0, 0, 0);
        c01 = __builtin_amdgcn_mfma_f32_32x32x16_bf16(A0b, B1b, c01, 0, 0, 0);
        c10 = __builtin_amdgcn_mfma_f32_32x32x16_bf16(A1b, B0b, c10, 0, 0, 0);
        c11 = __builtin_amdgcn_mfma_f32_32x32x16_bf16(A1b, B1b, c11, 0, 0, 0);
    }
}
#define FOR_ACC(c00, c01, c10, c11, ...) do { const int hi_ = C.lane >> 5, cl_ = C.lane & 31; \
    _Pragma("unroll") for (int r_ = 0; r_ < 16; ++r_) { const int rl_ = crow(r_, hi_); \
        { const int rloc = rl_, cloc = cl_; const float val = c00[r_]; __VA_ARGS__ } \
        { const int rloc = rl_, cloc = 32 + cl_; const float val = c01[r_]; __VA_ARGS__ } \
        { const int rloc = 32 + rl_, cloc = cl_; const float val = c10[r_]; __VA_ARGS__ } \
        { const int rloc = 32 + rl_, cloc = 32 + cl_; const float val = c11[r_]; __VA_ARGS__ } } } while (0)

namespace pg {
constexpr int BM = 256, BK = 64, HALF = 128, HTB = HALF * BK * 2, STAGE_BYTES = 8 * HTB, NXCD = 8, WGM = 8;
__device__ __forceinline__ int lds_byte(int r, int c) { const int st = (r >> 4) * 2 + (c >> 5), rr = r & 15, cc = c & 31, ob = rr * 64 + cc * 2; return st * 1024 + (ob ^ (((ob >> 9) & 1) << 5)); }
__device__ __forceinline__ void stage_rc(int b, int& R, int& C) { const int st = b / 1024, sb = b % 1024, swz = sb ^ (((sb >> 9) & 1) << 5); R = (st >> 1) * 16 + swz / 64; C = (st & 1) * 32 + (swz % 64) / 2; }
__device__ __forceinline__ int perm32(int rho) { const int n = rho >> 4, i = rho & 15; return 8 * (i >> 2) + 4 * n + (i & 3); }
__device__ __forceinline__ unsigned cvt_pk_bf16(float lo, float hi) { unsigned r; asm volatile("v_cvt_pk_bf16_f32 %0, %1, %2" : "=v"(r) : "v"(lo), "v"(hi)); return r; }

struct Unit { const char* A; const char* B; int pm, pn, e, cnt, off, mi; };

struct DenseOrder {
    static constexpr bool GATHER = false;
    const char* A; const char* Bt; int K, lda, nM, nN, nwg, G, c;
    __device__ __forceinline__ void init(const void* A_, const void* Bt_, int M, int N, int K_, int G_, int c_) { A = (const char*)A_; Bt = (const char*)Bt_; K = K_; lda = K_; nM = M / BM; nN = N / BM; nwg = nM * nN; G = G_; c = c_; }
    __device__ __forceinline__ bool next(int i, Unit& u) const {
        const long L = (long)i * G + c; if (L >= nwg) return false;
        int wgid = (int)L; { const int q = nwg / NXCD, r = nwg % NXCD, xcd = wgid % NXCD, off = wgid / NXCD; wgid = (xcd < r ? xcd * (q + 1) : r * (q + 1) + (xcd - r) * q) + off; }
        const int nig = WGM * nN, gid = wgid / nig, fm = gid * WGM, gsz = (nM - fm) < WGM ? (nM - fm) : WGM;
        u.pm = fm + ((wgid % nig) % gsz); u.pn = (wgid % nig) / gsz; u.e = 0; u.cnt = 0; u.off = 0; u.mi = 0;
        u.A = A + (size_t)u.pm * BM * K * 2; u.B = Bt + (size_t)u.pn * BM * K * 2; return true;
    }
    __device__ __forceinline__ void rows(const Unit&, const int (&R)[2], const int (&Cc)[2], unsigned (&v0)[2], unsigned (&v1)[2]) const {
#pragma unroll
        for (int i = 0; i < 2; ++i) { v0[i] = (unsigned)(R[i] * lda + Cc[i]) * 2u; v1[i] = v0[i] + (unsigned)(HALF * lda * 2); }
    }
};
struct OneUnit {
    static constexpr bool GATHER = false;
    const char* A; const char* B; int lda, pm, e;
    __device__ __forceinline__ bool next(int i, Unit& u) const { if (i) return false; u.A = A; u.B = B; u.pm = pm; u.pn = 0; u.e = e; u.cnt = 0; u.off = 0; u.mi = 0; return true; }
    __device__ __forceinline__ void rows(const Unit&, const int (&R)[2], const int (&Cc)[2], unsigned (&v0)[2], unsigned (&v1)[2]) const {
#pragma unroll
        for (int i = 0; i < 2; ++i) { v0[i] = (unsigned)(R[i] * lda + Cc[i]) * 2u; v1[i] = v0[i] + (unsigned)(HALF * lda * 2); }
    }
};

template <class Epi, class Sched, bool ALIGN_EPI>
__device__ __forceinline__ void gemm_phase(LAS unsigned char* lds, int K, const Sched& S, const Epi& E, int wid, int lane) {
    const int tid = wid * 64 + lane, wr = wid >> 2, wc = wid & 3, fr = lane & 15, fq = lane >> 4;
    const int nt = K / BK;
    int Rr[2], Cc[2]; unsigned voffB[2];
#pragma unroll
    for (int i = 0; i < 2; ++i) { stage_rc(tid * 16 + i * 8192, Rr[i], Cc[i]); const int Rb = Epi::PERM ? ((Rr[i] & ~31) + perm32(Rr[i] & 31)) : Rr[i]; voffB[i] = (unsigned)(Rb * K + Cc[i]) * 2u; }
    const size_t kstep = (size_t)(BK * 2);
    const size_t hstep = (size_t)HALF * K * 2;
    const unsigned ldsw = (unsigned)wid * 1024u;
    const int aoff = lds_byte(wr * 64 + fr, fq * 8), boff = lds_byte(wc * 32 + fr, fq * 8);
#define PG8_SA(b, h) (((b) * 2 + (h)) * HTB)
#define PG8_SB(b, h) ((4 + (b) * 2 + (h)) * HTB)
#define PG8_STAGE(bufoff, gbase, voff) do { _Pragma("unroll") for (int _i = 0; _i < 2; ++_i) \
        __builtin_amdgcn_global_load_lds((const unsigned*)((const char*)(gbase) + (voff)[_i]), (LAS unsigned*)(lds + (bufoff) + ldsw + _i * 8192), 16, 0, 0); } while (0)
#define PG8_LDA(dst, b, h) do { _Pragma("unroll") for (int m = 0; m < 4; ++m) _Pragma("unroll") for (int k = 0; k < 2; ++k) dst[m][k] = *(const LAS bf16x8*)(lds + PG8_SA(b, h) + aoff + m * 2048 + k * 1024); } while (0)
#define PG8_LDB(dst, b, h) do { _Pragma("unroll") for (int n = 0; n < 2; ++n) _Pragma("unroll") for (int k = 0; k < 2; ++k) dst[n][k] = *(const LAS bf16x8*)(lds + PG8_SB(b, h) + boff + n * 2048 + k * 1024); } while (0)
#define PG8_MMA(ai, bj, At, Bt) do { __builtin_amdgcn_s_setprio(1); _Pragma("unroll") for (int m = 0; m < 4; ++m) _Pragma("unroll") for (int n = 0; n < 2; ++n) _Pragma("unroll") for (int k = 0; k < 2; ++k) \
        acc[ai][bj][m][n] = __builtin_amdgcn_mfma_f32_16x16x32_bf16(Bt[n][k], At[m][k], acc[ai][bj][m][n], 0, 0, 0); __builtin_amdgcn_s_setprio(0); } while (0)
#define PG8_WAIT_V(n) asm volatile("s_waitcnt vmcnt(" #n ")" ::: "memory")
#define PG8_WAIT_L(n) asm volatile("s_waitcnt lgkmcnt(" #n ")" ::: "memory")
#define PG8_BAR __builtin_amdgcn_s_barrier()
#define PG8_SCHED __builtin_amdgcn_sched_barrier(0)
    Unit cur, nxt; int ui = 0;
    if (!S.next(0, cur)) return;
    f32x4 acc[2][2][4][2];
#pragma unroll
    for (int a = 0; a < 2; ++a)
#pragma unroll
        for (int b = 0; b < 2; ++b)
#pragma unroll
            for (int m = 0; m < 4; ++m)
#pragma unroll
                for (int n = 0; n < 2; ++n) acc[a][b][m][n] = (f32x4){0.f, 0.f, 0.f, 0.f};
    bf16x8 At[4][2], B0[2][2], B1[2][2];
    const char* cA = cur.A; const char* cB = cur.B;
    unsigned cv0[2], cv1[2], nv0[2], nv1[2];
    S.rows(cur, Rr, Cc, cv0, cv1);
    PG8_STAGE(PG8_SB(0, 0), cB, voffB); PG8_STAGE(PG8_SB(0, 1), cB + hstep, voffB); PG8_STAGE(PG8_SA(0, 0), cA, cv0); PG8_STAGE(PG8_SA(0, 1), cA, cv1);
    if (wr == 1) PG8_BAR;
    PG8_WAIT_V(2); PG8_BAR;
    PG8_STAGE(PG8_SB(1, 0), cB + kstep, voffB); PG8_STAGE(PG8_SA(1, 0), cA + kstep, cv0); PG8_STAGE(PG8_SB(1, 1), cB + hstep + kstep, voffB);
    PG8_WAIT_V(6); PG8_BAR;
    for (;;) {
        const bool has_next = S.next(ui + 1, nxt);
        const char* nA = has_next ? nxt.A : cA; const char* nB = has_next ? nxt.B : cB;
        if (has_next) S.rows(nxt, Rr, Cc, nv0, nv1); else { nv0[0] = cv0[0]; nv0[1] = cv0[1]; nv1[0] = cv1[0]; nv1[1] = cv1[1]; }
        for (int t = 0; t < nt; t += 2) {
            const bool last = (t == nt - 2);
            const char* a1 = cA + (size_t)(t + 1) * kstep;
            const char* a2 = last ? nA : cA + (size_t)(t + 2) * kstep; const char* b2 = last ? nB : cB + (size_t)(t + 2) * kstep;
            const char* a3 = a2 + kstep; const char* b3 = b2 + kstep;
            unsigned w0[2], w1[2];
            w0[0] = last ? nv0[0] : cv0[0]; w0[1] = last ? nv0[1] : cv0[1]; w1[0] = last ? nv1[0] : cv1[0]; w1[1] = last ? nv1[1] : cv1[1];
            PG8_LDB(B0, 0, 0); PG8_LDB(B1, 0, 1); PG8_SCHED; PG8_LDA(At, 0, 0); PG8_STAGE(PG8_SA(1, 1), a1, cv1);
            PG8_WAIT_V(8); PG8_WAIT_L(0); PG8_BAR; PG8_MMA(0, 0, At, B0); PG8_MMA(0, 1, At, B1); PG8_BAR; PG8_SCHED;
            PG8_LDA(At, 0, 1); PG8_STAGE(PG8_SB(0, 0), b2, voffB); PG8_STAGE(PG8_SB(0, 1), b2 + hstep, voffB); PG8_STAGE(PG8_SA(0, 0), a2, w0);
            PG8_WAIT_V(8); PG8_WAIT_L(0); PG8_BAR; PG8_MMA(1, 0, At, B0); PG8_MMA(1, 1, At, B1); PG8_BAR; PG8_SCHED;
            PG8_LDB(B0, 1, 0); PG8_LDB(B1, 1, 1); PG8_SCHED; PG8_LDA(At, 1, 0); PG8_STAGE(PG8_SA(0, 1), a2, w1);
            PG8_WAIT_V(8); PG8_WAIT_L(0); PG8_BAR; PG8_MMA(0, 0, At, B0); PG8_MMA(0, 1, At, B1); PG8_BAR; PG8_SCHED;
            PG8_LDA(At, 1, 1); PG8_STAGE(PG8_SB(1, 0), b3, voffB); PG8_STAGE(PG8_SB(1, 1), b3 + hstep, voffB); PG8_STAGE(PG8_SA(1, 0), a3, w0);
            PG8_WAIT_V(8); PG8_WAIT_L(0); PG8_BAR; PG8_MMA(1, 0, At, B0); PG8_MMA(1, 1, At, B1); PG8_BAR; PG8_SCHED;
        }
        if constexpr (ALIGN_EPI) { if (wr == 0) PG8_BAR; }
        if constexpr (!Epi::AFTER_DRAIN) E(acc, cur, wr, wc, fr, fq);
        if (!has_next) break;
#pragma unroll
        for (int a = 0; a < 2; ++a)
#pragma unroll
            for (int b = 0; b < 2; ++b)
#pragma unroll
                for (int m = 0; m < 4; ++m)
#pragma unroll
                    for (int n = 0; n < 2; ++n) acc[a][b][m][n] = (f32x4){0.f, 0.f, 0.f, 0.f};
        cur = nxt; cA = nA; cB = nB; ++ui; cv0[0] = nv0[0]; cv0[1] = nv0[1]; cv1[0] = nv1[0]; cv1[1] = nv1[1];
        if constexpr (ALIGN_EPI) { if (wr == 1) PG8_BAR; }
    }
    PG8_WAIT_V(0);
    if constexpr (!ALIGN_EPI) { if (wr == 0) PG8_BAR; }
    PG8_BAR;
    if constexpr (Epi::AFTER_DRAIN) E.fused(acc, cur, wr, wc, fr, fq, lds);
#undef PG8_SA
#undef PG8_SB
#undef PG8_STAGE
#undef PG8_LDA
#undef PG8_LDB
#undef PG8_MMA
#undef PG8_WAIT_V
#undef PG8_WAIT_L
#undef PG8_BAR
#undef PG8_SCHED
}
}

struct EpiQKVU {
    static constexpr bool PERM = true, AFTER_DRAIN = false;
    bf16_t* Q; bf16_t* UX;
    __device__ __forceinline__ void operator()(const f32x4 (&acc)[2][2][4][2], const pg::Unit& u, int wr, int wc, int fr, int fq) const {
        const int row0 = u.pm * 256 + wr * 64 + fr, colt = u.pn * 256, t = colt >> 9, cl = colt & 511, col0 = cl + wc * 32 + 8 * fq;
        const float sc = (t == 0) ? C2 : 1.0f;
#pragma unroll
        for (int ai = 0; ai < 2; ++ai)
#pragma unroll
            for (int m = 0; m < 4; ++m) { const int row = row0 + ai * 128 + m * 16;
#pragma unroll
                for (int bj = 0; bj < 2; ++bj) { const f32x4 v0 = acc[ai][bj][m][0] * sc, v1 = acc[ai][bj][m][1] * sc;
                    u32x4 w; w.x = pg::cvt_pk_bf16(v0[0], v0[1]); w.y = pg::cvt_pk_bf16(v0[2], v0[3]); w.z = pg::cvt_pk_bf16(v1[0], v1[1]); w.w = pg::cvt_pk_bf16(v1[2], v1[3]);
                    const int c = col0 + bj * 128;
                    if (t < 3) *(u32x4*)(Q + (size_t)t * (16u << 20) + (size_t)row * AW + c) = w;
                    else { const int g = c >> 4, h0 = c & 15; *(u32x4*)(UX + ((size_t)(g * 2048 + (row >> 4))) * UXK + (row & 15) * 16 + h0) = w; } } }
    }
};
struct EpiGLU {
    static constexpr bool PERM = true, AFTER_DRAIN = false;
    const bf16_t* Y; bf16_t* YCAT; const float* bglu;
    __device__ __forceinline__ void operator()(const f32x4 (&acc)[2][2][4][2], const pg::Unit& u, int wr, int wc, int fr, int fq) const {
        const int row0 = u.pm * 256 + wr * 64 + fr, col0 = u.pn * 256 + wc * 32 + 8 * fq;
#pragma unroll
        for (int bj = 0; bj < 2; ++bj) { const int c = col0 + bj * 128; const f32x4 b0 = *(const f32x4*)(bglu + c), b1 = *(const f32x4*)(bglu + c + 4);
#pragma unroll
            for (int ai = 0; ai < 2; ++ai)
#pragma unroll
                for (int m = 0; m < 4; ++m) { const int row = row0 + ai * 128 + m * 16;
                    const u32x4 yw = *(const u32x4*)(Y + (size_t)row * SWD + c);
                    const f32x4 s0 = acc[ai][bj][m][0] + b0, s1 = acc[ai][bj][m][1] + b1; float o[8];
#pragma unroll
                    for (int i = 0; i < 4; ++i) { const float ya = bf2f((unsigned short)(yw[i] & 0xffff)), yb = bf2f((unsigned short)(yw[i] >> 16));
                        const float sa = (i < 2) ? s0[2 * i] : s1[2 * i - 4], sb = (i < 2) ? s0[2 * i + 1] : s1[2 * i - 3];
                        o[2 * i] = ya * sigmoidf_(sa); o[2 * i + 1] = yb * sigmoidf_(sb); }
                    u32x4 w; w.x = pg::cvt_pk_bf16(o[0], o[1]); w.y = pg::cvt_pk_bf16(o[2], o[3]); w.z = pg::cvt_pk_bf16(o[4], o[5]); w.w = pg::cvt_pk_bf16(o[6], o[7]);
                    *(u32x4*)(YCAT + (size_t)row * DM + 512 + c) = w; } }
    }
};
struct EpiMix {
    static constexpr bool PERM = false, AFTER_DRAIN = false;
    float* out;
    __device__ __forceinline__ void operator()(const f32x4 (&acc)[2][2][4][2], const pg::Unit& u, int wr, int wc, int fr, int fq) const {
        const int row0 = u.pm * 256 + wr * 64 + fr, col0 = u.pn * 256 + wc * 32 + 4 * fq;
#pragma unroll
        for (int ai = 0; ai < 2; ++ai)
#pragma unroll
            for (int m = 0; m < 4; ++m) { float* rp = out + (size_t)(row0 + ai * 128 + m * 16) * DM + col0;
#pragma unroll
                for (int bj = 0; bj < 2; ++bj)
#pragma unroll
                    for (int n = 0; n < 2; ++n) *(f32x4*)(rp + bj * 128 + n * 16) = acc[ai][bj][m][n]; }
    }
};
struct MoeOrder {
    static constexpr bool GATHER = true;
    const char* A; const char* Bt; const int* LIST; LAS const int* tab; int K, G, vcu; size_t bstride; bool gather;
    __device__ __forceinline__ bool next(int i, pg::Unit& u) const {
        const int L = i * G + vcu, total = __builtin_amdgcn_readfirstlane(tab[32]);
        if (L >= total * 4) return false;
        const int mt = L >> 2; int lo = 0, hi = 32;
#pragma unroll
        for (int s = 0; s < 5; ++s) { const int mid = (lo + hi) >> 1; const int tv = __builtin_amdgcn_readfirstlane(tab[mid]); if (tv <= mt) lo = mid; else hi = mid; }
        const int e = lo;
        u.e = e; u.pn = L & 3; u.mi = mt - __builtin_amdgcn_readfirstlane(tab[e]); u.cnt = __builtin_amdgcn_readfirstlane(tab[40 + e]); u.off = __builtin_amdgcn_readfirstlane(tab[80 + e]); u.pm = 0;
        u.B = Bt + (size_t)e * bstride + (size_t)u.pn * 256 * K * 2;
        u.A = gather ? A : A + (size_t)(u.off + u.mi * 256) * K * 2;
        return true;
    }
    __device__ __forceinline__ void rows(const pg::Unit& u, const int (&R)[2], const int (&Cc)[2], unsigned (&v0)[2], unsigned (&v1)[2]) const {
        if (gather) {
#pragma unroll
            for (int i = 0; i < 2; ++i) { const int s0 = u.mi * 256 + R[i], s1 = s0 + 128;
                const int t0 = (s0 < u.cnt) ? (LIST[(size_t)u.e * T + s0] >> 1) : 0, t1 = (s1 < u.cnt) ? (LIST[(size_t)u.e * T + s1] >> 1) : 0;
                v0[i] = (unsigned)(t0 * K + Cc[i]) * 2u; v1[i] = (unsigned)(t1 * K + Cc[i]) * 2u; }
        } else {
#pragma unroll
            for (int i = 0; i < 2; ++i) { v0[i] = (unsigned)(R[i] * K + Cc[i]) * 2u; v1[i] = v0[i] + (unsigned)(128 * K * 2); }
        }
    }
};
struct EpiHid {
    static constexpr bool PERM = true, AFTER_DRAIN = false;
    bf16_t* HID;
    __device__ __forceinline__ void operator()(const f32x4 (&acc)[2][2][4][2], const pg::Unit& u, int wr, int wc, int fr, int fq) const {
        const int c = u.pn * 128 + wc * 32 + 8 * fq;
#pragma unroll
        for (int ai = 0; ai < 2; ++ai)
#pragma unroll
            for (int m = 0; m < 4; ++m) { const int slot = u.mi * 256 + ai * 128 + wr * 64 + m * 16 + fr;
                if (slot < u.cnt) { float o[8];
#pragma unroll
                    for (int n = 0; n < 2; ++n)
#pragma unroll
                        for (int i = 0; i < 4; ++i) { const float g = acc[ai][0][m][n][i], up = acc[ai][1][m][n][i]; o[4 * n + i] = g * sigmoidf_(g) * up; }
                    u32x4 w; w.x = pg::cvt_pk_bf16(o[0], o[1]); w.y = pg::cvt_pk_bf16(o[2], o[3]); w.z = pg::cvt_pk_bf16(o[4], o[5]); w.w = pg::cvt_pk_bf16(o[6], o[7]);
                    *(u32x4*)(HID + (size_t)(u.off + slot) * DE + c) = w; } }
    }
};
struct EpiDown {
    static constexpr bool PERM = true, AFTER_DRAIN = false;
    bf16_t* YASG; const int* LIST; const float* GATE;
    __device__ __forceinline__ void operator()(const f32x4 (&acc)[2][2][4][2], const pg::Unit& u, int wr, int wc, int fr, int fq) const {
        const int c = u.pn * 256 + wc * 32 + 8 * fq;
#pragma unroll
        for (int ai = 0; ai < 2; ++ai)
#pragma unroll
            for (int m = 0; m < 4; ++m) { const int slot = u.mi * 256 + ai * 128 + wr * 64 + m * 16 + fr;
                if (slot < u.cnt) { const int a = LIST[(size_t)u.e * T + slot]; const float gt = GATE[a];
#pragma unroll
                    for (int bj = 0; bj < 2; ++bj) { const f32x4 v0 = acc[ai][bj][m][0] * gt, v1 = acc[ai][bj][m][1] * gt;
                        u32x4 w; w.x = pg::cvt_pk_bf16(v0[0], v0[1]); w.y = pg::cvt_pk_bf16(v0[2], v0[3]); w.z = pg::cvt_pk_bf16(v1[0], v1[1]); w.w = pg::cvt_pk_bf16(v1[2], v1[3]);
                        *(u32x4*)(YASG + (size_t)a * DM + c + bj * 128) = w; } } }
    }
};
constexpr int TAB_OFF = 131072;
__device__ __forceinline__ int vcu_of(const Ctx& C) { return (C.G % 8 == 0) ? (C.wgid % 8) * (C.G / 8) + C.wgid / 8 : C.wgid; }
__device__ __forceinline__ void moe_tables(const Ctx& C) {
    LAS int* tab = (LAS int*)(C.lds + TAB_OFF);
    if (C.wave == 0) {
        const int lane = C.lane;
        const int c = (lane < 32) ? (int)__hip_atomic_load(C.ctl_() + CW_CNT + lane, __ATOMIC_RELAXED, __HIP_MEMORY_SCOPE_AGENT) : 0;
        const int tl = (c + 255) >> 8; int inc = tl, incc = c;
#pragma unroll
        for (int o = 1; o < 32; o <<= 1) { const int t1 = __shfl_up(inc, o), t2 = __shfl_up(incc, o); if ((lane & 31) >= o) { inc += t1; incc += t2; } }
        if (lane < 32) { tab[lane] = inc - tl; tab[40 + lane] = c; tab[80 + lane] = incc - c; }
        if (lane == 31) tab[32] = inc;
    }
    __syncthreads();
}
__device__ __forceinline__ void ph_gemm1(const Ctx& C) {
    pg::DenseOrder S; S.init(C.XB_(), C.Win_(), T, 2048, DM, C.G, C.wgid);
    EpiQKVU E{C.Q_(), C.UX_()};
    pg::gemm_phase<EpiQKVU, pg::DenseOrder, true>(C.lds, DM, S, E, C.wave, C.lane);
}
__device__ __forceinline__ void ph_glu(const Ctx& C) {
    pg::DenseOrder S; S.init(C.Y_(), C.Wglu_(), T, SWD, SWD, C.G, C.wgid);
    EpiGLU E{C.Y_(), C.YCAT_(), C.b_glu_()};
    pg::gemm_phase<EpiGLU, pg::DenseOrder, true>(C.lds, SWD, S, E, C.wave, C.lane);
}
__device__ __forceinline__ void ph_wout(const Ctx& C) {
    pg::DenseOrder S; S.init(C.YCAT_(), C.Wout_(), T, DM, DM, C.G, C.wgid);
    EpiMix E{C.out_()};
    pg::gemm_phase<EpiMix, pg::DenseOrder, true>(C.lds, DM, S, E, C.wave, C.lane);
}
__device__ __forceinline__ void ph_moe_up(const Ctx& C) {
    moe_tables(C);
    MoeOrder S{(const char*)C.HB_(), (const char*)C.Wgu_(), C.LIST_(), (LAS const int*)(C.lds + TAB_OFF), DM, C.G, vcu_of(C), (size_t)1024 * 1024 * 2, true};
    EpiHid E{C.HID_()};
    pg::gemm_phase<EpiHid, MoeOrder, true>(C.lds, DM, S, E, C.wave, C.lane);
}
__device__ __forceinline__ void ph_moe_down(const Ctx& C) {
    moe_tables(C);
    MoeOrder S{(const char*)C.HID_(), (const char*)C.Wd_(), C.LIST_(), (LAS const int*)(C.lds + TAB_OFF), DE, C.G, vcu_of(C), (size_t)1024 * 512 * 2, false};
    EpiDown E{C.YASG_(), C.LIST_(), C.GATE_()};
    pg::gemm_phase<EpiDown, MoeOrder, true>(C.lds, DE, S, E, C.wave, C.lane);
}

__device__ __forceinline__ void transpose_item(const float* W, int ldw, bf16_t* WT, int ldt, int k0, int n0src, int drow0, LAS float* scr, int lane) {
#pragma unroll 8
    for (int i = 0; i < 32; ++i) { const int kk = 2 * i + (lane >> 5); scr[kk * 33 + (lane & 31)] = W[(size_t)(k0 + kk) * ldw + n0src + (lane & 31)]; }
    asm volatile("s_waitcnt lgkmcnt(0)" ::: "memory");
    const int c = lane & 7;
#pragma unroll
    for (int j = 0; j < 4; ++j) { const int n = (lane >> 3) + 8 * j; const LAS float* s = scr + (8 * c) * 33 + n;
        u32x4 o; o.x = pk2(s[0 * 33], s[1 * 33]); o.y = pk2(s[2 * 33], s[3 * 33]); o.z = pk2(s[4 * 33], s[5 * 33]); o.w = pk2(s[6 * 33], s[7 * 33]);
        *(u32x4*)(WT + (size_t)(drow0 + n) * ldt + k0 + 8 * c) = o; }
    asm volatile("s_waitcnt lgkmcnt(0)" ::: "memory");
}

__device__ __forceinline__ void s5_tables(const Ctx& C, int g) {
    LAS float* L = (LAS float*)C.lds;
    LAS float* apr = L; LAS float* api = L + 1088; LAS float* bbr = L + 2176; LAS float* bbi = L + 3200;
    LAS float* cr = L + 4224; LAS float* ci = L + 5248; LAS float* Kt = L + 6272;
    const int tid = C.tid;
    if (tid < 64) {
        const int p = tid;
        const float lr = C.lam_re_()[g * 64 + p], li = C.lam_im_()[g * 64 + p], dl = expf(C.log_step_()[g]);
        const float mag = expf(lr * dl), ang = li * dl;
        const float a1r = mag * cosf(ang), a1i = mag * sinf(ang);
        float pr = 1.f, pi = 0.f;
        for (int j = 0; j <= 16; ++j) { apr[j * 64 + p] = pr; api[j * 64 + p] = pi; const float nr = pr * a1r - pi * a1i, ni = pr * a1i + pi * a1r; pr = nr; pi = ni; }
        C.S5A_()[(g * 64 + p) * 2 + 0] = apr[16 * 64 + p]; C.S5A_()[(g * 64 + p) * 2 + 1] = api[16 * 64 + p];
        const float den = lr * lr + li * li, nre = a1r - 1.0f;
        const float cre = (nre * lr + a1i * li) / den, cim = (a1i * lr - nre * li) / den;
        for (int h = 0; h < 16; ++h) { const float br = C.b_re_()[(g * 64 + p) * 16 + h], bi = C.b_im_()[(g * 64 + p) * 16 + h];
            bbr[p * 16 + h] = cre * br - cim * bi; bbi[p * 16 + h] = cre * bi + cim * br; }
    }
    for (int idx = tid; idx < 1024; idx += 512) { const int h = idx >> 6, p = idx & 63; cr[idx] = C.c_re_()[(g * 16 + h) * 64 + p]; ci[idx] = C.c_im_()[(g * 16 + h) * 64 + p]; }
    __syncthreads();
    for (int idx = tid; idx < 4096; idx += 512) { const int j = idx >> 8, h = (idx >> 4) & 15, hp = idx & 15; float s = 0.f;
        for (int p = 0; p < 64; ++p) { const float c_r = cr[h * 64 + p], c_i = ci[h * 64 + p], ar = apr[j * 64 + p], ai = api[j * 64 + p];
            const float mr = c_r * ar - c_i * ai, mi = c_r * ai + c_i * ar; s += mr * bbr[p * 16 + hp] - mi * bbi[p * 16 + hp]; }
        Kt[idx] = s; }
    __syncthreads();
    for (int ch = tid; ch < 256 * 48; ch += 512) { const int n = ch / 48, kc = ch - n * 48, k0 = kc * 8, tl = n >> 4, h = n & 15; float v[8];
        if (k0 < 256) { const int sl = k0 >> 4, hp0 = k0 & 15;
#pragma unroll
            for (int i = 0; i < 8; ++i) v[i] = (tl >= sl) ? Kt[((tl - sl) * 16 + h) * 16 + hp0 + i] : 0.f;
        } else {
#pragma unroll
            for (int i = 0; i < 8; ++i) { const int q = k0 - 256 + i, p = q & 63, im = q >> 6, j = tl + 1; const float c_r = cr[h * 64 + p], c_i = ci[h * 64 + p], ar = apr[j * 64 + p], ai = api[j * 64 + p];
                v[i] = im ? -(c_r * ai + c_i * ar) : (c_r * ar - c_i * ai); }
        }
        u32x4 o; o.x = pk2(v[0], v[1]); o.y = pk2(v[2], v[3]); o.z = pk2(v[4], v[5]); o.w = pk2(v[6], v[7]);
        *(u32x4*)(C.S5W_() + ((size_t)(g * 256 + n)) * UXK + k0) = o; }
    for (int ch = tid; ch < 128 * 32; ch += 512) { const int n = ch >> 5, k0 = (ch & 31) * 8, sl = k0 >> 4, hp0 = k0 & 15, p = n & 63, im = n >> 6, j = 15 - sl; float v[8];
        const float ar = apr[j * 64 + p], ai = api[j * 64 + p];
#pragma unroll
        for (int i = 0; i < 8; ++i) { const float br = bbr[p * 16 + hp0 + i], bi = bbi[p * 16 + hp0 + i]; v[i] = im ? (ar * bi + ai * br) : (ar * br - ai * bi); }
        u32x4 o; o.x = pk2(v[0], v[1]); o.y = pk2(v[2], v[3]); o.z = pk2(v[4], v[5]); o.w = pk2(v[6], v[7]);
        *(u32x4*)(C.S5S_() + ((size_t)(g * 256 + n)) * 256 + k0) = o; }
    for (int ch = tid; ch < 128 * 32; ch += 512) { const int n = 128 + (ch >> 5), k0 = (ch & 31) * 8; *(u32x4*)(C.S5S_() + ((size_t)(g * 256 + n)) * 256 + k0) = (u32x4){0u, 0u, 0u, 0u}; }
    __syncthreads();
}

__device__ __forceinline__ void ph_prologue(const Ctx& C) {
    for (int g = C.wgid; g < NG; g += C.G) s5_tables(C, g);
    __syncthreads();
    LAS float* scr = (LAS float*)C.lds + C.wave * 2112;
    constexpr int I_QKV = 16 * 48, I_U = 16 * 16, I_GLU = 8 * 16, I_OUT = 16 * 32, I_GU1 = 16 * 16, I_D1 = 8 * 32;
    constexpr int NITEMS = I_QKV + I_U + I_GLU + I_OUT + NE * 2 * I_GU1 + NE * I_D1;
    for (int it = C.gw; it < NITEMS; it += C.NGW) {
        int r = it;
        if (r < I_QKV) { const int kb = r / 48, nb = r % 48; transpose_item(C.w_in_(), INC, C.Win_(), DM, 64 * kb, 32 * nb, 32 * nb, scr, C.lane); continue; } r -= I_QKV;
        if (r < I_U) { const int kb = r / 16, nb = r % 16; transpose_item(C.w_in_(), INC, C.Win_(), DM, 64 * kb, 1544 + 32 * nb, 1536 + 32 * nb, scr, C.lane); continue; } r -= I_U;
        if (r < I_GLU) { const int kb = r / 16, nb = r % 16; transpose_item(C.w_glu_(), SWD, C.Wglu_(), SWD, 64 * kb, 32 * nb, 32 * nb, scr, C.lane); continue; } r -= I_GLU;
        if (r < I_OUT) { const int kb = r / 32, nb = r % 32; transpose_item(C.w_out_(), DM, C.Wout_(), DM, 64 * kb, 32 * nb, 32 * nb, scr, C.lane); continue; } r -= I_OUT;
        if (r < NE * 2 * I_GU1) { const int e = r / (2 * I_GU1), r2 = r % (2 * I_GU1), up = r2 / I_GU1, r3 = r2 % I_GU1, kb = r3 / 16, nb = r3 % 16;
            const float* W = (up ? C.w_up_() : C.w_gate_()) + (size_t)e * DM * DE; const int n0 = 32 * nb; const int drow = 256 * (n0 >> 7) + 128 * up + (n0 & 127);
            transpose_item(W, DE, C.Wgu_() + (size_t)e * 1024 * 1024, DM, 64 * kb, n0, drow, scr, C.lane); continue; } r -= NE * 2 * I_GU1;
        { const int e = r / I_D1, r2 = r % I_D1, kb = r2 / 32, nb = r2 % 32;
            transpose_item(C.w_down_() + (size_t)e * DE * DM, DM, C.Wd_() + (size_t)e * DM * DE, DE, 64 * kb, 32 * nb, 32 * nb, scr, C.lane); }
    }
    for (int n = C.gw; n < 48; n += C.NGW) {
        float w[16];
#pragma unroll
        for (int i = 0; i < 16; ++i) { const int kk = 16 * C.lane + i; w[i] = (n < 4) ? C.w_rg_()[(size_t)kk * 4 + n] : (n < 36) ? C.w_re_()[(size_t)kk * 32 + (n - 4)] : 0.f; }
        u32x4 h0, h1, l0, l1;
#pragma unroll
        for (int i = 0; i < 4; ++i) { const unsigned a0 = f2bf(w[2 * i]), a1 = f2bf(w[2 * i + 1]), a2 = f2bf(w[8 + 2 * i]), a3 = f2bf(w[8 + 2 * i + 1]);
            h0[i] = a0 | (a1 << 16); h1[i] = a2 | (a3 << 16);
            l0[i] = pk2(w[2 * i] - bf2f((unsigned short)a0), w[2 * i + 1] - bf2f((unsigned short)a1)); l1[i] = pk2(w[8 + 2 * i] - bf2f((unsigned short)a2), w[8 + 2 * i + 1] - bf2f((unsigned short)a3)); }
        bf16_t* ph = C.WR_() + (size_t)n * DM + 16 * C.lane; bf16_t* pl = ph + 48 * DM;
        *(u32x4*)ph = h0; *(u32x4*)(ph + 8) = h1; *(u32x4*)pl = l0; *(u32x4*)(pl + 8) = l1;
    }
    float wf[4][4][8];
#pragma unroll
    for (int j = 0; j < 4; ++j)
#pragma unroll
        for (int i = 0; i < 4; ++i)
#pragma unroll
            for (int hh = 0; hh < 8; ++hh) wf[j][i][hh] = C.w_in_()[(size_t)(256 * j + 4 * C.lane + i) * INC + 1536 + hh];
    for (int row = C.gw; row < T; row += C.NGW) {
        const f32x4* xr = (const f32x4*)(C.x_() + (size_t)row * DM) + C.lane;
        f32x4 v[4]; float fl[8];
#pragma unroll
        for (int hh = 0; hh < 8; ++hh) fl[hh] = 0.f;
#pragma unroll
        for (int j = 0; j < 4; ++j) { v[j] = xr[64 * j];
#pragma unroll
            for (int i = 0; i < 4; ++i)
#pragma unroll
                for (int hh = 0; hh < 8; ++hh) fl[hh] += v[j][i] * wf[j][i][hh]; }
        u32x2* o8 = (u32x2*)(C.XB_() + (size_t)row * DM) + C.lane;
#pragma unroll
        for (int j = 0; j < 4; ++j) { u32x2 w; w.x = pk2(v[j][0], v[j][1]); w.y = pk2(v[j][2], v[j][3]); o8[64 * j] = w; }
#pragma unroll
        for (int hh = 0; hh < 8; ++hh) fl[hh] = wave_sum(fl[hh]);
        float mine = 0.f;
#pragma unroll
        for (int hh = 0; hh < 8; ++hh) mine = (C.lane == hh) ? fl[hh] : mine;
        if (C.lane < 8) { const float z = mine + C.b_fgate_()[C.lane]; const float ls = fminf(z, 0.f) - log1pf(__expf(-fabsf(z)));
            const int b = row / SEQ, t = row % SEQ; C.LOGF_()[((size_t)(b * NH + C.lane)) * SEQ + t] = ls; }
    }
}

__device__ __forceinline__ void ph_cumscan(const Ctx& C) {
    for (int s = C.gw; s < BATCH * NH; s += C.NGW) {
        const float* src = C.LOGF_() + (size_t)s * SEQ + 32 * C.lane; float v[32];
#pragma unroll
        for (int i = 0; i < 8; ++i) { const f32x4 t = *(const f32x4*)(src + 4 * i); v[4 * i] = t[0]; v[4 * i + 1] = t[1]; v[4 * i + 2] = t[2]; v[4 * i + 3] = t[3]; }
#pragma unroll
        for (int i = 1; i < 32; ++i) v[i] += v[i - 1];
        float tot = v[31], inc = tot;
#pragma unroll
        for (int o = 1; o < 64; o <<= 1) { const float t = __shfl_up(inc, o); if (C.lane >= o) inc += t; }
        const float off = inc - tot;
        float* dst = C.CUM_() + (size_t)s * SEQ + 32 * C.lane;
#pragma unroll
        for (int i = 0; i < 8; ++i) { f32x4 t; t[0] = (v[4 * i] + off) * LOG2E; t[1] = (v[4 * i + 1] + off) * LOG2E; t[2] = (v[4 * i + 2] + off) * LOG2E; t[3] = (v[4 * i + 3] + off) * LOG2E; *(f32x4*)(dst + 4 * i) = t; }
    }
}
namespace attn_body {
using bf16=__hip_bfloat16;
using bf16x8=__attribute__((ext_vector_type(8)))short;
using s16x4=__attribute__((ext_vector_type(4)))short;
using f32x16=__attribute__((ext_vector_type(16)))float;
using u32x4=__attribute__((ext_vector_type(4)))unsigned;
constexpr int BATCH=16,NHEAD=8,SEQ=2048,D=64,QP=512,OP=1024;
constexpr int NW=8,QBLK=32,QB=QBLK*NW,KVBLK=64,NQB=SEQ/QB;
constexpr int ATTN_UNIT_ROWS=QB;
__device__ __forceinline__ int crow(int r,int hi){return (r&3)+8*(r>>2)+4*hi;}
__device__ __forceinline__ unsigned f2bf_rne(float f){unsigned u=__builtin_bit_cast(unsigned,f);return (u+0x7fffu+((u>>16)&1u))>>16;}
#define SBAR() __builtin_amdgcn_sched_barrier(0)
__device__ __forceinline__ void cmask(f32x16&p0,f32x16&p1,int jb,int qrel,int hi){
  const float NEG=-INFINITY; int kb=64*jb+4*hi;
  #pragma unroll
  for(int r=0;r<16;++r){int kv=kb+(r&3)+8*(r>>2); if(kv>qrel)p0[r]=NEG; if(kv+32>qrel)p1[r]=NEG;}
}

constexpr int NSLOT=3, SLOTB=8192;
constexpr int LDS_K=0, LDS_V=NSLOT*SLOTB, LDS_WS=2*NSLOT*SLOTB, LDS_OST=LDS_WS+NW*64*4, LDS_TAB=LDS_OST+NW*4096, LDS_BYTES=LDS_TAB+SEQ*16;
constexpr float C2=0.125f*1.4426950408889634f;
__device__ __forceinline__ void glds16(const void*gsrc,unsigned lds_dst){unsigned keep;
  asm volatile("s_mov_b32 %0, m0\n\ts_mov_b32 m0, %2\n\ts_nop 0\n\tglobal_load_lds_dwordx4 %1, off\n\ts_mov_b32 m0, %0":"=&s"(keep):"v"(gsrc),"s"(lds_dst):"memory");}
__device__ __forceinline__ float max3f(float a,float b,float c){float r;asm("v_max3_f32 %0, %1, %2, %3":"=v"(r):"v"(a),"v"(b),"v"(c));return r;}
__device__ __forceinline__ float max2f(float a,float b){float r;asm("v_max_f32_e32 %0, %1, %2":"=v"(r):"v"(a),"v"(b));return r;}
__device__ __forceinline__ float fadd_s(float a,float b){float r;asm("v_add_f32_e32 %0, %1, %2":"=v"(r):"v"(a),"v"(b));return r;}
__device__ __forceinline__ float fsub_s(float a,float b){float r;asm("v_sub_f32_e32 %0, %1, %2":"=v"(r):"v"(a),"v"(b));return r;}
typedef float f32x2_t __attribute__((ext_vector_type(2))); typedef __bf16 bf16x2_t __attribute__((ext_vector_type(2)));
__device__ __forceinline__ unsigned cvtpk_s(float lo,float hi){f32x2_t v={lo,hi};bf16x2_t b=__builtin_convertvector(v,bf16x2_t);return __builtin_bit_cast(unsigned,b);}
#define WAIT_BAR(N) asm volatile("s_waitcnt vmcnt(" #N ") lgkmcnt(0)\n\ts_barrier":::"memory")

__device__ __forceinline__ void qkt(f32x16&p0,f32x16&p1,const char*Kslot,const bf16x8*qr,bf16x8 ke0,bf16x8 ke1,bf16x8 qext,int r32,int hi){
  const char*kb=Kslot+hi*1024+r32*16;
  #pragma unroll
  for(int d0=0;d0<4;++d0){
    const bf16x8 b0=*reinterpret_cast<const bf16x8*>(kb+d0*2048);
    const bf16x8 b1=*reinterpret_cast<const bf16x8*>(kb+d0*2048+512);
    if(d0==0){p0=__builtin_amdgcn_mfma_f32_32x32x16_bf16(ke0,qext,f32x16{},0,0,0);p1=__builtin_amdgcn_mfma_f32_32x32x16_bf16(ke1,qext,f32x16{},0,0,0);
      p0=__builtin_amdgcn_mfma_f32_32x32x16_bf16(b0,qr[0],p0,0,0,0);p1=__builtin_amdgcn_mfma_f32_32x32x16_bf16(b1,qr[0],p1,0,0,0);}
    else{p0=__builtin_amdgcn_mfma_f32_32x32x16_bf16(b0,qr[d0],p0,0,0,0);p1=__builtin_amdgcn_mfma_f32_32x32x16_bf16(b1,qr[d0],p1,0,0,0);}}
}
typedef __attribute__((address_space(3))) const char* lds_cptr;
typedef short v4i16_t __attribute__((ext_vector_type(4)));
__device__ __forceinline__ void kload8(bf16x8*kf,lds_cptr kp){
  kf[0]=*(const __attribute__((address_space(3))) bf16x8*)(kp);      kf[1]=*(const __attribute__((address_space(3))) bf16x8*)(kp+512);
  kf[2]=*(const __attribute__((address_space(3))) bf16x8*)(kp+2048); kf[3]=*(const __attribute__((address_space(3))) bf16x8*)(kp+2560);
  kf[4]=*(const __attribute__((address_space(3))) bf16x8*)(kp+4096); kf[5]=*(const __attribute__((address_space(3))) bf16x8*)(kp+4608);
  kf[6]=*(const __attribute__((address_space(3))) bf16x8*)(kp+6144); kf[7]=*(const __attribute__((address_space(3))) bf16x8*)(kp+6656);
}
__device__ __forceinline__ void kload2(bf16x8*kf,lds_cptr kp,int j){ kf[2*j]=*(const __attribute__((address_space(3))) bf16x8*)(kp+j*2048); kf[2*j+1]=*(const __attribute__((address_space(3))) bf16x8*)(kp+j*2048+512); }
__device__ __forceinline__ s16x4 vtr(lds_cptr p){ return __builtin_bit_cast(s16x4,__builtin_amdgcn_ds_read_tr16_b64_v4i16((__attribute__((address_space(3))) v4i16_t*)p)); }
__device__ __forceinline__ float rowmax(const f32x16&p0,const f32x16&p1){
  float a=max3f(p0[0],p0[1],p1[0]),b=max3f(p0[2],p0[3],p1[1]);a=max3f(a,p1[2],p1[3]);
  #pragma unroll
  for(int r=4;r<16;r+=4){a=max3f(a,p0[r],p0[r+1]);b=max3f(b,p0[r+2],p0[r+3]);a=max3f(a,p1[r],p1[r+1]);b=max3f(b,p1[r+2],p1[r+3]);}
  const float m=max2f(a,b);
  auto rr=__builtin_amdgcn_permlane32_swap(__float_as_uint(m),__float_as_uint(m),false,false);
  return max2f(__uint_as_float(rr[0]),__uint_as_float(rr[1]));
}
__device__ __forceinline__ void pv(f32x16*o,int vb,bf16x8 pa0,bf16x8 pa1,bf16x8 pa2,bf16x8 pa3){
  #pragma unroll
  for(int d0=0;d0<2;++d0){s16x4 lo[4],hi[4];
    #pragma unroll
    for(int ks=0;ks<4;++ks){
      asm volatile("ds_read_b64_tr_b16 %0,%1 offset:%c2":"=&v"(lo[ks]):"v"(vb),"i"(d0*4096+ks*1024):"memory");
      asm volatile("ds_read_b64_tr_b16 %0,%1 offset:%c2":"=&v"(hi[ks]):"v"(vb),"i"(d0*4096+ks*1024+512):"memory");}
    asm volatile("s_waitcnt lgkmcnt(0)":::"memory");SBAR();
    #define PK(k) (bf16x8){lo[k][0],lo[k][1],lo[k][2],lo[k][3],hi[k][0],hi[k][1],hi[k][2],hi[k][3]}
    o[d0]=__builtin_amdgcn_mfma_f32_32x32x16_bf16(pa0,PK(0),o[d0],0,0,0);
    o[d0]=__builtin_amdgcn_mfma_f32_32x32x16_bf16(pa1,PK(1),o[d0],0,0,0);
    o[d0]=__builtin_amdgcn_mfma_f32_32x32x16_bf16(pa2,PK(2),o[d0],0,0,0);
    o[d0]=__builtin_amdgcn_mfma_f32_32x32x16_bf16(pa3,PK(3),o[d0],0,0,0);
    #undef PK
  }
}

#ifndef ATTN_STORE16
#define ATTN_STORE16(p,v) (*(u32x4*)(p)=(v))
#endif
template<int THRL> __device__ __forceinline__ void attn_unit(int b,int h,int qb,const bf16*Q,const bf16*__restrict__ K,const bf16*__restrict__ V,bf16*O,const float*__restrict__ CUM2,char*shm,const int wid,const int lane){
  const int tid=wid*64+lane,r32=lane&31,hi=lane>>5;
  const long rowbase=(long)b*SEQ; const int q0=qb*QB;
  const bf16*Qw=Q+(rowbase+q0+wid*QBLK)*QP+h*D;
  const bf16*Kh=K+rowbase*QP+h*D,*Vh=V+rowbase*QP+h*D;
  const unsigned lds0=(unsigned)(uintptr_t)shm;
  float*wsf=(float*)(shm+LDS_WS)+wid*64;
  const bf16*ksrc=Kh+(long)lane*QP+wid*8;
  const bf16*vsrc=Vh+(long)(16*(wid&3)+(lane>>2))*QP+(wid>>2)*32+(lane&3)*8;
  const unsigned kdst=lds0+LDS_K+wid*1024, vdst=lds0+LDS_V+wid*1024;
  #define DMA_K(t,slot) glds16(ksrc+(long)(t)*KVBLK*QP,(unsigned)__builtin_amdgcn_readfirstlane(kdst+(slot)))
  #define DMA_V(t,slot) glds16(vsrc+(long)(t)*KVBLK*QP,(unsigned)__builtin_amdgcn_readfirstlane(vdst+(slot)))
  const int vb0=(int)(lds0+LDS_V)+((lane>>4)&1)*32+(lane&3)*8+(4*hi+((lane&15)>>2))*64;
  const char*Kbase=shm+LDS_K; bf16x8 kf[8];
  const lds_cptr shm3=(lds_cptr)shm; const lds_cptr kp0=shm3+LDS_K+hi*1024+r32*16; const lds_cptr vp0=shm3+LDS_V+((lane>>4)&1)*32+(lane&3)*8+(4*hi+((lane&15)>>2))*64;
  const int NT=(q0+QB)/KVBLK;
  DMA_K(0,0);DMA_V(0,0);DMA_K(1,SLOTB);
  { const float*cum=CUM2+(long)(b*NHEAD+h)*SEQ; const float cref=cum[q0]; const lds_cptr tb=(lds_cptr)shm+LDS_TAB;
    for(int kv=tid;kv<q0+QB;kv+=NW*64){ const float c=cref-cum[kv]; const unsigned b1=f2bf_rne(c); const float r1=c-__uint_as_float(b1<<16); const unsigned b2=f2bf_rne(r1); const float r2=r1-__uint_as_float(b2<<16); const unsigned b3=f2bf_rne(r2);
      u32x4 w; w.x=b1|(b2<<16); w.y=b3|(0x3F80u<<16); w.z=0x3F80u|(0x3F80u<<16); w.w=0u; *(__attribute__((address_space(3))) u32x4*)(tb+kv*16)=w; } }
  const lds_cptr tabp=(lds_cptr)shm+LDS_TAB+r32*16;
  u32x4 qextw; qextw.x=hi?0u:(0x3F80u|(0x3F80u<<16)); qextw.y=hi?0u:0x3F80u; qextw.z=0u; qextw.w=0u;
  #define SET_QEXT(mh) do{ const float nm_=-(mh); const unsigned m1_=f2bf_rne(nm_); const float q1_=nm_-__uint_as_float(m1_<<16); const unsigned m2_=f2bf_rne(q1_); const float q2_=q1_-__uint_as_float(m2_<<16); const unsigned m3_=f2bf_rne(q2_); \
    qextw.y=hi?0u:(0x3F80u|(m1_<<16)); qextw.z=hi?0u:(m2_|(m3_<<16)); }while(0)
  #define QEXT __builtin_bit_cast(bf16x8,qextw)
  #define KEXT(t,half) (*(const __attribute__((address_space(3))) bf16x8*)(tabp+((t)*KVBLK+(half)*32)*16))
  bf16x8 qr[2];
  const lds_cptr qst=(lds_cptr)shm+LDS_OST+wid*4096+lane*16;
  #define QLD(i) (*(const __attribute__((address_space(3))) bf16x8*)(qst+(i)*1024))
  { bf16x8 qt[4];
    #pragma unroll
    for(int d0=0;d0<4;++d0)qt[d0]=*reinterpret_cast<const bf16x8*>(&Qw[(long)r32*QP+d0*16+hi*8]);
    qr[0]=qt[0];qr[1]=qt[1]; *(__attribute__((address_space(3))) bf16x8*)(qst)=qt[2]; *(__attribute__((address_space(3))) bf16x8*)(qst+1024)=qt[3]; }
  float mhat=0.f,l_reg=0.f;f32x16 o[2];o[0]=f32x16{};o[1]=f32x16{};
  const int qrel=wid*QBLK+r32;
  #define CMASK(P0,P1,t) do{int jb_=(t)-(NT-4); if(jb_>=0)cmask(P0,P1,jb_,qrel,hi);}while(0)
  bool resc=false;
  #define START(P0,P1) do{ const float rm=rowmax(P0,P1); resc=false; \
    { const float dl=rm; mhat=fadd_s(mhat,dl); \
      _Pragma("unroll") for(int r=0;r<16;++r){P0[r]=fsub_s(P0[r],dl);P1[r]=fsub_s(P1[r],dl);} \
      SET_QEXT(mhat); } \
    _Pragma("unroll") for(int r=0;r<16;++r)P0[r]=__builtin_amdgcn_exp2f(P0[r]); }while(0)
  #define RESC() do{ if(resc){ asm volatile("s_waitcnt lgkmcnt(0)":::"memory"); \
      _Pragma("unroll") for(int d_=0;d_<2;++d_) _Pragma("unroll") for(int r=0;r<16;++r)o[d_][r]*=wsf[crow(r,hi)]; } }while(0)
  f32x16 pA0,pA1,pB0,pB1;
  int sl_prev=0,sl_cur=0,sl_next=SLOTB;
  #define ROT() do{sl_prev=sl_cur;sl_cur=sl_next;sl_next=(sl_next==(NSLOT-1)*SLOTB)?0:sl_next+SLOTB;}while(0)
  DMA_K(2,2*SLOTB);
  WAIT_BAR(3);
  { bf16x8 q4[4]; q4[0]=qr[0];q4[1]=qr[1];q4[2]=QLD(0);q4[3]=QLD(1); qkt(pA0,pA1,Kbase,q4,KEXT(0,0),KEXT(0,1),QEXT,r32,hi); }asm volatile("s_nop 15\n\ts_nop 7":"+v"(pA0),"+v"(pA1));CMASK(pA0,pA1,0);
  START(pA0,pA1);
  _Pragma("unroll") for(int r=0;r<16;++r)pA1[r]=__builtin_amdgcn_exp2f(pA1[r]);
  WAIT_BAR(0);
  DMA_K(3,0);DMA_V(1,SLOTB);
  ROT();
  kload8(kf,kp0+sl_cur);
  WAIT_BAR(2);
  s16x4 vlo[8],vhi[8]; u32x4 pw0,pw1,pw2,pw3;
  #define PKW(P,B) cvtpk_s(P[B],P[B+1])
  #define PAF(k) __builtin_bit_cast(bf16x8,pw##k)
  #define VFR(i) (bf16x8){vlo[i][0],vlo[i][1],vlo[i][2],vlo[i][3],vhi[i][0],vhi[i][1],vhi[i][2],vhi[i][3]}
  #define PIN(x) asm volatile("":"+v"(x))
  #define MX3(a,b,c) __builtin_fmaxf(__builtin_fmaxf((a),(b)),(c))
  #define GAPA(MF,A0,A1,A2,A3,W0,W1,PW) do{ MF; sacc+=A0; sacc+=A1; sacc+=A2; sacc+=A3; PIN(sacc); W0; W1; PIN(PW); SBAR(); }while(0)
  #define EX(v) __builtin_amdgcn_exp2f(v)
  #define GAPB(MF,X,B) do{ MF; X[B]=EX(X[B]); X[B+1]=EX(X[B+1]); X[B+2]=EX(X[B+2]); X[B+3]=EX(X[B+3]); PIN(X); SBAR(); }while(0)
  #define VRD(i) do{ vlo[i]=vtr(vp_+(((i)>>2)*4096+((i)&3)*1024)); vhi[i]=vtr(vp_+(((i)>>2)*4096+((i)&3)*1024+512)); }while(0)
  #define KRD(G,j) do{ if(G){ kload2(kf,kp0+sl_next,j); SBAR(); } }while(0)
  #define STEP(C0,C1,P0,P1,t,GK,GV,GL) do{ SBAR(); \
    const lds_cptr vp_=vp0+sl_prev; \
    VRD(0); SBAR(); float sacc=(P0[0]+P0[1]); \
    GAPA(C0=__builtin_amdgcn_mfma_f32_32x32x16_bf16(kf[0],qr[0],f32x16{},0,0,0), P0[2],P0[3],P0[4],P0[5],     pw0[0]=PKW(P0,0), pw0[1]=PKW(P0,2), pw0); \
    VRD(4); SBAR(); GAPA(C1=__builtin_amdgcn_mfma_f32_32x32x16_bf16(kf[1],qr[0],f32x16{},0,0,0), P0[6],P0[7],P0[8],P0[9],     pw0[2]=PKW(P0,4), pw0[3]=PKW(P0,6), pw0); \
    VRD(1); const bf16x8 qc_=QLD(0); SBAR(); GAPA(C0=__builtin_amdgcn_mfma_f32_32x32x16_bf16(kf[2],qr[1],C0,0,0,0),   P0[10],P0[11],P0[12],P0[13], pw1[0]=PKW(P0,8), pw1[1]=PKW(P0,10), pw1); \
    VRD(5); SBAR(); GAPA(C1=__builtin_amdgcn_mfma_f32_32x32x16_bf16(kf[3],qr[1],C1,0,0,0),   P0[14],P0[15],P1[0],P1[1],   pw1[2]=PKW(P0,12),pw1[3]=PKW(P0,14), pw1); \
    VRD(2); const bf16x8 qd_=QLD(1); SBAR(); GAPA(C0=__builtin_amdgcn_mfma_f32_32x32x16_bf16(kf[4],qc_,C0,0,0,0),   P1[2],P1[3],P1[4],P1[5],     pw2[0]=PKW(P1,0), pw2[1]=PKW(P1,2), pw2); \
    VRD(6); SBAR(); GAPA(C1=__builtin_amdgcn_mfma_f32_32x32x16_bf16(kf[5],qc_,C1,0,0,0),   P1[6],P1[7],P1[8],P1[9],     pw2[2]=PKW(P1,4), pw2[3]=PKW(P1,6), pw2); \
    VRD(3); SBAR(); GAPA(C0=__builtin_amdgcn_mfma_f32_32x32x16_bf16(kf[6],qd_,C0,0,0,0),   P1[10],P1[11],P1[12],P1[13], pw3[0]=PKW(P1,8), pw3[1]=PKW(P1,10), pw3); \
    VRD(7); SBAR(); GAPA(C1=__builtin_amdgcn_mfma_f32_32x32x16_bf16(kf[7],qd_,C1,0,0,0),   P1[14],P1[15],0.f,0.f,       pw3[2]=PKW(P1,12),pw3[3]=PKW(P1,14), pw3); \
    l_reg+=sacc; \
    { const bf16x8 ke0_=KEXT(t,0), ke1_=KEXT(t,1); C0=__builtin_amdgcn_mfma_f32_32x32x16_bf16(ke0_,QEXT,C0,0,0,0); C1=__builtin_amdgcn_mfma_f32_32x32x16_bf16(ke1_,QEXT,C1,0,0,0); } SBAR(); \
    if(GK){DMA_K((t)+3,sl_cur);} if(GV){DMA_V((t)+1,sl_next);} \
    CMASK(C0,C1,t); \
    { float a=MX3(C0[0],C0[1],C1[0]),b=MX3(C0[2],C0[3],C1[1]); a=MX3(a,C1[2],C1[3]); \
      _Pragma("unroll") for(int r=4;r<16;r+=4){a=MX3(a,C0[r],C0[r+1]);b=MX3(b,C0[r+2],C0[r+3]);a=MX3(a,C1[r],C1[r+1]);b=MX3(b,C1[r+2],C1[r+3]);} \
      float rm=__builtin_fmaxf(a,b); { auto rr=__builtin_amdgcn_permlane32_swap(__float_as_uint(rm),__float_as_uint(rm),false,false); rm=__builtin_fmaxf(__uint_as_float(rr[0]),__uint_as_float(rr[1])); } \
      resc=false; \
      if(__builtin_expect(__any(rm>(float)THRL),0)){ const float dl=__builtin_fmaxf(rm,0.f); mhat+=dl; \
        _Pragma("unroll") for(int r=0;r<16;++r){C0[r]-=dl;C1[r]-=dl;} \
        SET_QEXT(mhat); \
        const float f=__builtin_amdgcn_exp2f(-dl); l_reg*=f; if(hi==0)wsf[r32]=f; resc=true; } } \
    SBAR(); \
    GAPB(o[0]=__builtin_amdgcn_mfma_f32_32x32x16_bf16(PAF(0),VFR(0),o[0],0,0,0), C0,0); \
    GAPB(o[1]=__builtin_amdgcn_mfma_f32_32x32x16_bf16(PAF(0),VFR(4),o[1],0,0,0), C0,4); \
    KRD(GL,0); GAPB(o[0]=__builtin_amdgcn_mfma_f32_32x32x16_bf16(PAF(1),VFR(1),o[0],0,0,0), C0,8); \
    KRD(GL,1); GAPB(o[1]=__builtin_amdgcn_mfma_f32_32x32x16_bf16(PAF(1),VFR(5),o[1],0,0,0), C0,12); \
    KRD(GL,2); GAPB(o[0]=__builtin_amdgcn_mfma_f32_32x32x16_bf16(PAF(2),VFR(2),o[0],0,0,0), C1,0); \
    KRD(GL,3); GAPB(o[1]=__builtin_amdgcn_mfma_f32_32x32x16_bf16(PAF(2),VFR(6),o[1],0,0,0), C1,4); \
    GAPB(o[0]=__builtin_amdgcn_mfma_f32_32x32x16_bf16(PAF(3),VFR(3),o[0],0,0,0), C1,8); \
    GAPB(o[1]=__builtin_amdgcn_mfma_f32_32x32x16_bf16(PAF(3),VFR(7),o[1],0,0,0), C1,12); \
    }while(0)
  int t=1;
  #undef CMASK
  #define CMASK(P0,P1,t) do{}while(0)
  for(;t+5<NT;t+=2){
    STEP(pB0,pB1,pA0,pA1,t,true,true,true);     WAIT_BAR(2); RESC(); ROT();
    STEP(pA0,pA1,pB0,pB1,t+1,true,true,true);   WAIT_BAR(2); RESC(); ROT();
  }
  #undef CMASK
  #define CMASK(P0,P1,t) do{int jb_=(t)-(NT-4); if(jb_>=0)cmask(P0,P1,jb_,qrel,hi);}while(0)
  #define ENDW(tt) do{ if((tt)+3<NT){WAIT_BAR(2);} else if((tt)+2<NT){WAIT_BAR(1);} else {WAIT_BAR(0);} }while(0)
  for(;t+1<NT;t+=2){
    STEP(pB0,pB1,pA0,pA1,t,(t+3<NT),(t+1<NT),(t+1<NT));       ENDW(t);   RESC(); ROT();
    STEP(pA0,pA1,pB0,pB1,t+1,(t+4<NT),(t+2<NT),(t+2<NT));     ENDW(t+1); RESC(); ROT();
  }
  STEP(pB0,pB1,pA0,pA1,NT-1,false,false,false); RESC();
  { float sacc=pB0[0]+pB0[1]; _Pragma("unroll") for(int r=2;r<16;++r)sacc+=pB0[r]; _Pragma("unroll") for(int r=0;r<16;++r)sacc+=pB1[r]; l_reg+=sacc;
    pw0=(u32x4){PKW(pB0,0),PKW(pB0,2),PKW(pB0,4),PKW(pB0,6)};pw1=(u32x4){PKW(pB0,8),PKW(pB0,10),PKW(pB0,12),PKW(pB0,14)};pw2=(u32x4){PKW(pB1,0),PKW(pB1,2),PKW(pB1,4),PKW(pB1,6)};pw3=(u32x4){PKW(pB1,8),PKW(pB1,10),PKW(pB1,12),PKW(pB1,14)};
    SBAR(); pv(o,vb0+sl_cur,PAF(0),PAF(1),PAF(2),PAF(3)); }
  #undef PKW
  #undef PAF
  #undef VFR
  #undef PIN
  #undef MX3
  #undef GAPA
  #undef GAPB
  #undef EX
  #undef VRD
  #undef KRD
  #undef STEP
  #undef ENDW
  {auto rr=__builtin_amdgcn_permlane32_swap(__float_as_uint(l_reg),__float_as_uint(l_reg),false,false);l_reg=__uint_as_float(rr[0])+__uint_as_float(rr[1]);}
  if(hi==0)wsf[32+r32]=l_reg;asm volatile("s_waitcnt lgkmcnt(0)":::"memory");
  float rli[16];
  #pragma unroll
  for(int r=0;r<16;++r)rli[r]=__builtin_amdgcn_rcpf(wsf[32+crow(r,hi)]);
  bf16*Ow=O+(rowbase+q0+wid*QBLK)*OP+h*D;
  { bf16*stg=(bf16*)(shm+LDS_OST)+wid*2048;
    #pragma unroll
    for(int r=0;r<16;++r){const int orow=crow(r,hi);
      #pragma unroll
      for(int d0=0;d0<2;++d0)stg[orow*64+d0*32+r32]=__float2bfloat16(o[d0][r]*rli[r]);}
    asm volatile("s_waitcnt lgkmcnt(0)":::"memory");
    #pragma unroll
    for(int i=0;i<4;++i){const int row=i*8+(lane>>3),ch=lane&7; const u32x4 v=*(const u32x4*)(stg+row*64+ch*8); ATTN_STORE16(Ow+(long)row*OP+ch*8,v);} }
  asm volatile("s_waitcnt lgkmcnt(0)\n\ts_barrier":::"memory");
  #undef DMA_K
  #undef DMA_V
  #undef QLD
  #undef SET_QEXT
  #undef QEXT
  #undef KEXT
  #undef CMASK
  #undef START
  #undef RESC
  #undef ROT
}
constexpr int ATTN_LDS_BYTES=LDS_BYTES;
struct AttnTensors { const bf16* Q; const bf16* K; const bf16* V; bf16* O; const float* CUM2; int wid, lane; };
struct AttnUnit { int bh; int qb; };
struct StaticOrder {
  int vcu, G;
  __device__ __forceinline__ explicit StaticOrder(int grid,int block):vcu((grid%8==0)?(block%8)*(grid/8)+block/8:block),G(grid){}
  __device__ __forceinline__ bool next(int i,AttnUnit&u)const{
    if(G==256){ if(i>=4)return false; const int s=(vcu&1)*2+(i>>1); u.bh=vcu>>1; u.qb=(i&1)?7-s:s; return true; }
    const int id=i*G+vcu; if(id>=BATCH*NHEAD*NQB)return false; u.bh=id%(BATCH*NHEAD); u.qb=NQB-1-id/(BATCH*NHEAD); return true; }
  __device__ __forceinline__ void a_ready(const AttnUnit&)const{}
  __device__ __forceinline__ void done(const AttnUnit&)const{}
};
template<class Sched,int THRL=8> __device__ __forceinline__ void attn_phase(char*lds,const AttnTensors&T,const Sched&S){
  AttnUnit u;
  for(int i=0;S.next(i,u);++i){ S.a_ready(u); attn_unit<THRL>(u.bh/NHEAD,u.bh%NHEAD,u.qb,T.Q,T.K,T.V,T.O,T.CUM2,lds,T.wid,T.lane); S.done(u); }
}
#undef SBAR
#undef WAIT_BAR
}
__device__ __forceinline__ void ph_attention(const Ctx& C) {
    static_assert(attn_body::ATTN_LDS_BYTES <= 131072, "attention LDS");
    const attn_body::AttnTensors AT{(const attn_body::bf16*)C.Q_(), (const attn_body::bf16*)C.K_(), (const attn_body::bf16*)C.V_(), (attn_body::bf16*)C.YCAT_(), C.CUM_(), C.wave, C.lane};
    const attn_body::StaticOrder S(C.G, C.wgid);
    attn_body::attn_phase<attn_body::StaticOrder>((char*)C.lds, AT, S);
}
struct EpiSloc {
    static constexpr bool PERM = false, AFTER_DRAIN = true;
    __device__ __forceinline__ void fused(const f32x4 (&acc)[2][2][4][2], const pg::Unit&, int wr, int wc, int fr, int fq, LAS unsigned char* lds) const {
        LAS float* S = (LAS float*)lds;
#pragma unroll
        for (int ai = 0; ai < 2; ++ai)
#pragma unroll
            for (int m = 0; m < 4; ++m) { const int r = ai * 128 + wr * 64 + m * 16 + fr;
#pragma unroll
                for (int n = 0; n < 2; ++n) *(LAS f32x4*)(S + r * 132 + wc * 32 + n * 16 + 4 * fq) = acc[ai][0][m][n]; }
    }
};
struct EpiY {
    static constexpr bool PERM = true, AFTER_DRAIN = false;
    const bf16_t* UX; bf16_t* Y; const float* dskip;
    __device__ __forceinline__ void operator()(const f32x4 (&acc)[2][2][4][2], const pg::Unit& u, int wr, int wc, int fr, int fq) const {
        const int g = u.e;
#pragma unroll
        for (int bj = 0; bj < 2; ++bj) { const int n0 = bj * 128 + wc * 32 + 8 * fq, tl = n0 >> 4, h0 = n0 & 15;
            const f32x4 d0 = *(const f32x4*)(dskip + g * 16 + h0), d1 = *(const f32x4*)(dskip + g * 16 + h0 + 4);
#pragma unroll
            for (int ai = 0; ai < 2; ++ai)
#pragma unroll
                for (int m = 0; m < 4; ++m) { const int row = u.pm * 256 + ai * 128 + wr * 64 + m * 16 + fr;
                    const u32x4 uw = *(const u32x4*)(UX + ((size_t)(g * 2048 + row)) * UXK + n0); float o[8];
#pragma unroll
                    for (int i = 0; i < 4; ++i) { const float ua = bf2f((unsigned short)(uw[i] & 0xffff)), ub = bf2f((unsigned short)(uw[i] >> 16));
                        const float aa = (i < 2) ? acc[ai][bj][m][0][2 * i] : acc[ai][bj][m][1][2 * i - 4], ab = (i < 2) ? acc[ai][bj][m][0][2 * i + 1] : acc[ai][bj][m][1][2 * i - 3];
                        const float da = (i < 2) ? d0[2 * i] : d1[2 * i - 4], db = (i < 2) ? d0[2 * i + 1] : d1[2 * i - 3];
                        o[2 * i] = gelu_tanh(aa + da * ua); o[2 * i + 1] = gelu_tanh(ab + db * ub); }
                    u32x4 w; w.x = pg::cvt_pk_bf16(o[0], o[1]); w.y = pg::cvt_pk_bf16(o[2], o[3]); w.z = pg::cvt_pk_bf16(o[4], o[5]); w.w = pg::cvt_pk_bf16(o[6], o[7]);
                    *(u32x4*)(Y + ((size_t)row * 16 + tl) * SWD + g * 16 + h0) = w;
                    if (m & 1) asm volatile("" ::: "memory"); } }
    }
};
__device__ __forceinline__ void ph_s5(const Ctx& C) {
    const int vcu = (C.G % 8 == 0) ? (C.wgid % 8) * (C.G / 8) + C.wgid / 8 : C.wgid;
    for (int unit = vcu; unit < NG * 8; unit += C.G) {
        const int g = unit >> 3, bp = unit & 7;
        const bf16_t* Arows = C.UX_() + ((size_t)(g * 2048 + bp * 256)) * UXK;
        { pg::OneUnit S{(const char*)Arows, (const char*)(C.S5S_() + (size_t)g * 256 * 256), UXK, bp, g}; EpiSloc E{};
          pg::gemm_phase<EpiSloc, pg::OneUnit, true>(C.lds, 256, S, E, C.wave, lane_id_v()); }
        asm volatile("s_waitcnt lgkmcnt(0)" ::: "memory"); __syncthreads();
        { LAS float* S = (LAS float*)C.lds; LAS float* EL = S + 256 * 132;
          const int seg = C.wave >> 1, bl = C.wave & 1, p = lane_id_v();
          const float ar = C.S5A_()[(g * 64 + p) * 2], ai = C.S5A_()[(g * 64 + p) * 2 + 1];
          const LAS float* sp = S + (bl * 128 + seg * 32) * 132 + p;
          float xr = 0.f, xi = 0.f;
          for (int c = 0; c < 32; ++c) { const float sr = sp[c * 132], si = sp[c * 132 + 64]; const float nr = ar * xr - ai * xi + sr, ni = ar * xi + ai * xr + si; xr = nr; xi = ni; }
          EL[(seg * 2 + bl) * 128 + p] = xr; EL[(seg * 2 + bl) * 128 + 64 + p] = xi;
          float pr = ar, pi = ai;
#pragma unroll
          for (int q = 0; q < 5; ++q) { const float nr = pr * pr - pi * pi, ni = 2.f * pr * pi; pr = nr; pi = ni; }
          asm volatile("s_waitcnt lgkmcnt(0)" ::: "memory"); __syncthreads();
          xr = 0.f; xi = 0.f;
          for (int s2 = 0; s2 < seg; ++s2) { const float er = EL[(s2 * 2 + bl) * 128 + p], ei = EL[(s2 * 2 + bl) * 128 + 64 + p]; const float nr = pr * xr - pi * xi + er, ni = pr * xi + pi * xr + ei; xr = nr; xi = ni; }
          bf16_t* xo = C.UX_() + ((size_t)(g * 2048 + bp * 256 + bl * 128 + seg * 32)) * UXK + 256 + p;
          for (int c = 0; c < 32; ++c) { xo[(size_t)c * UXK] = (bf16_t)f2bf(xr); xo[(size_t)c * UXK + 64] = (bf16_t)f2bf(xi);
              const float sr = sp[c * 132], si = sp[c * 132 + 64]; const float nr = ar * xr - ai * xi + sr, ni = ar * xi + ai * xr + si; xr = nr; xi = ni; }
        }
        asm volatile("s_waitcnt vmcnt(0) lgkmcnt(0)" ::: "memory"); __syncthreads();
        { pg::OneUnit S{(const char*)Arows, (const char*)(C.S5W_() + (size_t)g * 256 * UXK), UXK, bp, g}; EpiY E{C.UX_(), C.Y_(), C.dskip_()};
          pg::gemm_phase<EpiY, pg::OneUnit, true>(C.lds, UXK, S, E, C.wave, lane_id_v()); }
    }
}
__device__ __forceinline__ void ph_norm(const Ctx& C) {
    for (int row = C.gw; row < T; row += C.NGW) {
        bf16_t* p = C.YCAT_() + (size_t)row * DM + 16 * C.lane;
        const u32x4 w0 = *(const u32x4*)p, w1 = *(const u32x4*)(p + 8); float v[16];
#pragma unroll
        for (int i = 0; i < 4; ++i) { v[2 * i] = bf2f((unsigned short)(w0[i] & 0xffff)); v[2 * i + 1] = bf2f((unsigned short)(w0[i] >> 16)); v[8 + 2 * i] = bf2f((unsigned short)(w1[i] & 0xffff)); v[8 + 2 * i + 1] = bf2f((unsigned short)(w1[i] >> 16)); }
        float ss = 0.f;
#pragma unroll
        for (int i = 0; i < 16; ++i) ss += v[i] * v[i];
#pragma unroll
        for (int o = 1; o < 32; o <<= 1) ss += __shfl_xor(ss, o);
        const float sc = 1.0f / sqrtf(ss * (1.0f / 512.0f) + RMS_EPS);
        const float* gp = (C.lane < 32) ? (C.attn_g_() + 16 * C.lane) : (C.ssm_g_() + 16 * (C.lane - 32));
#pragma unroll
        for (int i = 0; i < 16; ++i) v[i] = v[i] * sc * gp[i];
        u32x4 o0, o1;
#pragma unroll
        for (int i = 0; i < 4; ++i) { o0[i] = pk2(v[2 * i], v[2 * i + 1]); o1[i] = pk2(v[8 + 2 * i], v[8 + 2 * i + 1]); }
        *(u32x4*)p = o0; *(u32x4*)(p + 8) = o1;
    }
}
__device__ __forceinline__ void ph_ln1(const Ctx& C) {
    for (int row = C.gw; row < T; row += C.NGW) {
        const f32x4* xr = (const f32x4*)(C.x_() + (size_t)row * DM) + C.lane; f32x4* mr = (f32x4*)(C.out_() + (size_t)row * DM) + C.lane;
        f32x4 v[4]; float s = 0.f;
#pragma unroll
        for (int j = 0; j < 4; ++j) { v[j] = xr[64 * j] * ALPHA + mr[64 * j]; s += (v[j][0] + v[j][1]) + (v[j][2] + v[j][3]); }
        const float mean = wave_sum(s) * (1.0f / DM); float q = 0.f;
#pragma unroll
        for (int j = 0; j < 4; ++j) { v[j] = v[j] - mean; q += (v[j][0] * v[j][0] + v[j][1] * v[j][1]) + (v[j][2] * v[j][2] + v[j][3] * v[j][3]); }
        const float rstd = 1.0f / sqrtf(wave_sum(q) * (1.0f / DM) + LN_EPS);
        u32x2* hb = (u32x2*)(C.HB_() + (size_t)row * DM) + C.lane;
#pragma unroll
        for (int j = 0; j < 4; ++j) { const f32x4 g = *((const f32x4*)C.ln1_g_() + C.lane + 64 * j), bb = *((const f32x4*)C.ln1_b_() + C.lane + 64 * j);
            const f32x4 o = v[j] * rstd * g + bb; mr[64 * j] = o; u32x2 w; w.x = pk2(o[0], o[1]); w.y = pk2(o[2], o[3]); hb[64 * j] = w; }
    }
}
__device__ __forceinline__ void ph_router(const Ctx& C) {
    LAS float* LG = (LAS float*)C.lds + C.wave * (16 * 49);
    LAS int* hist = (LAS int*)(C.lds + 32768);
    const int lane = C.lane, r16 = lane & 15, kq = lane >> 4;
    for (int it = C.wgid; it < T / 128; it += C.G) {
        if (C.tid < 64) hist[C.tid] = 0;
        __syncthreads();
        const int tok0 = it * 128 + C.wave * 16;
        const float* hrow = C.out_() + (size_t)(tok0 + r16) * DM + 8 * kq;
        const bf16_t* wh = C.WR_() + (size_t)r16 * DM + 8 * kq;
        f32x4 acc[3]; acc[0] = (f32x4){0.f, 0.f, 0.f, 0.f}; acc[1] = acc[0]; acc[2] = acc[0];
        for (int kk = 0; kk < DM; kk += 32) {
            const f32x4 h0 = *(const f32x4*)(hrow + kk), h1 = *(const f32x4*)(hrow + kk + 4);
            bf16x8 ah, al;
#pragma unroll
            for (int i = 0; i < 8; ++i) { const float v = (i < 4) ? h0[i] : h1[i - 4]; const unsigned hb = f2bf(v); ah[i] = (short)hb; al[i] = (short)f2bf(v - bf2f((unsigned short)hb)); }
#pragma unroll
            for (int nb = 0; nb < 3; ++nb) { const bf16x8 bh = *(const bf16x8*)(wh + (size_t)nb * 16 * DM + kk), bl = *(const bf16x8*)(wh + (size_t)(48 + nb * 16) * DM + kk);
                acc[nb] = __builtin_amdgcn_mfma_f32_16x16x32_bf16(ah, bh, acc[nb], 0, 0, 0);
                acc[nb] = __builtin_amdgcn_mfma_f32_16x16x32_bf16(al, bh, acc[nb], 0, 0, 0);
                acc[nb] = __builtin_amdgcn_mfma_f32_16x16x32_bf16(ah, bl, acc[nb], 0, 0, 0); }
        }
#pragma unroll
        for (int nb = 0; nb < 3; ++nb)
#pragma unroll
            for (int r = 0; r < 4; ++r) LG[(4 * kq + r) * 49 + nb * 16 + r16] = acc[nb][r];
        asm volatile("s_waitcnt lgkmcnt(0)" ::: "memory");
        int e1 = 0, e2 = 0, pos1 = 0, pos2 = 0; float g1 = 0.f, g2 = 0.f;
        if (lane < 16) {
            float L[36];
#pragma unroll
            for (int i = 0; i < 36; ++i) L[i] = LG[lane * 49 + i] + ((i < 4) ? C.b_rg_()[i] : C.b_re2_()[i - 4]);
            int gi = 0; float gm = L[0];
#pragma unroll
            for (int c = 1; c < 4; ++c) if (L[c] > gm) { gm = L[c]; gi = c; }
            float gs = 0.f;
#pragma unroll
            for (int c = 0; c < 4; ++c) gs += __expf(L[c] - gm);
            const float gp = 1.0f / gs;
            float el[8];
#pragma unroll
            for (int i = 0; i < 8; ++i) el[i] = (gi == 0) ? L[4 + i] : (gi == 1) ? L[12 + i] : (gi == 2) ? L[20 + i] : L[28 + i];
            int i1 = 0; float l1 = el[0];
#pragma unroll
            for (int i = 1; i < 8; ++i) if (el[i] > l1) { l1 = el[i]; i1 = i; }
            int i2 = -1; float l2 = -INFINITY;
#pragma unroll
            for (int i = 0; i < 8; ++i) if (i != i1 && el[i] > l2) { l2 = el[i]; i2 = i; }
            const float p1 = 1.0f / (1.0f + __expf(l2 - l1));
            e1 = gi * 8 + i1; e2 = gi * 8 + i2; g1 = gp * p1; g2 = gp * (1.0f - p1);
            pos1 = __hip_atomic_fetch_add(&hist[e1], 1, __ATOMIC_RELAXED, __HIP_MEMORY_SCOPE_WORKGROUP);
            pos2 = __hip_atomic_fetch_add(&hist[e2], 1, __ATOMIC_RELAXED, __HIP_MEMORY_SCOPE_WORKGROUP);
        }
        __syncthreads();
        if (C.tid < 32) { const int n = hist[C.tid]; hist[32 + C.tid] = n ? (int)atomicAdd(C.ctl_() + CW_CNT + C.tid, (unsigned)n) : 0; }
        __syncthreads();
        if (lane < 16) { const int tok = tok0 + lane;
            C.LIST_()[(size_t)e1 * T + hist[32 + e1] + pos1] = 2 * tok; C.GATE_()[2 * tok] = g1;
            C.LIST_()[(size_t)e2 * T + hist[32 + e2] + pos2] = 2 * tok + 1; C.GATE_()[2 * tok + 1] = g2; }
        __syncthreads();
    }
}
__device__ __forceinline__ void ph_final(const Ctx& C) {
    for (int row = C.gw; row < T; row += C.NGW) {
        f32x4* hr = (f32x4*)(C.out_() + (size_t)row * DM) + C.lane;
        const u32x2* ya = (const u32x2*)(C.YASG_() + (size_t)(2 * row) * DM) + C.lane; const u32x2* yb = (const u32x2*)(C.YASG_() + (size_t)(2 * row + 1) * DM) + C.lane;
        f32x4 v[4]; float s = 0.f;
#pragma unroll
        for (int j = 0; j < 4; ++j) { const u32x2 a = ya[64 * j], b = yb[64 * j];
            f32x4 m; m[0] = bf2f((unsigned short)(a.x & 0xffff)) + bf2f((unsigned short)(b.x & 0xffff)); m[1] = bf2f((unsigned short)(a.x >> 16)) + bf2f((unsigned short)(b.x >> 16));
            m[2] = bf2f((unsigned short)(a.y & 0xffff)) + bf2f((unsigned short)(b.y & 0xffff)); m[3] = bf2f((unsigned short)(a.y >> 16)) + bf2f((unsigned short)(b.y >> 16));
            v[j] = hr[64 * j] * ALPHA + m; s += (v[j][0] + v[j][1]) + (v[j][2] + v[j][3]); }
        const float mean = wave_sum(s) * (1.0f / DM); float q = 0.f;
#pragma unroll
        for (int j = 0; j < 4; ++j) { v[j] = v[j] - mean; q += (v[j][0] * v[j][0] + v[j][1] * v[j][1]) + (v[j][2] * v[j][2] + v[j][3] * v[j][3]); }
        const float rstd = 1.0f / sqrtf(wave_sum(q) * (1.0f / DM) + LN_EPS);
#pragma unroll
        for (int j = 0; j < 4; ++j) { const f32x4 g = *((const f32x4*)C.ln2_g_() + C.lane + 64 * j), bb = *((const f32x4*)C.ln2_b_() + C.lane + 64 * j); hr[64 * j] = v[j] * rstd * g + bb; }
    }
}

constexpr int NPHASE = 11;
constexpr int LDS_BYTES = 147456;

#define XB_TMO      128
#define XB_XCNT(j)  (256  + 64 * (j))
#define XB_XSUB(j)  (1280 + 64 * (j))
#define XB_XGEN(j)  (2304 + 64 * (j))
#define XB_TOP      3328
#define XB_TOPGEN   3392
#define XCD_BAR_WORDS 3456
#define XB_SPIN_CAP (1u << 18)
constexpr int CW_BAR = 4096;
__device__ __forceinline__ unsigned xb_ld(unsigned* p)              { return __hip_atomic_load(p, __ATOMIC_RELAXED, __HIP_MEMORY_SCOPE_AGENT); }
__device__ __forceinline__ unsigned xb_add(unsigned* p, unsigned v) { return __hip_atomic_fetch_add(p, v, __ATOMIC_RELAXED, __HIP_MEMORY_SCOPE_AGENT); }
__device__ __forceinline__ unsigned xb_xcc_id() { return (unsigned)__builtin_amdgcn_s_getreg((3 << 11) | 20) & 0xFu; }
#define XB_SPIN(cond, bar) do { unsigned _sp = 0; while (cond) { __builtin_amdgcn_s_sleep(1); \
    if ((++_sp & 255u) == 0u) { if (xb_ld(&(bar)[XB_TMO])) break; if (_sp > XB_SPIN_CAP) { atomicAdd(&(bar)[XB_TMO], 1u); break; } } } } while (0)
struct XcdBarrier { unsigned* bar; unsigned x; volatile LAS unsigned* st; };
__device__ __forceinline__ XcdBarrier xcd_barrier_post(unsigned* bar, volatile LAS unsigned* st, bool leader) {
    XcdBarrier b; b.bar = bar; b.x = xb_xcc_id(); b.st = st;
    if (leader) (void)xb_add(&bar[XB_XCNT(b.x)], 1u);
    return b;
}
__device__ __forceinline__ void xcd_barrier_complete(unsigned* bar, unsigned x, unsigned& nloc, unsigned& nx) {
    const unsigned G = gridDim.x * gridDim.y * gridDim.z;
    unsigned sum, cnt, mine, sp = 0u;
    for (;;) {
        sum = 0u; cnt = 0u; mine = 0u;
#pragma unroll
        for (unsigned j = 0; j < 16; ++j) { const unsigned c = xb_ld(&bar[XB_XCNT(j)]); sum += c; cnt += (c > 0u) ? 1u : 0u; mine = (j == x) ? c : mine; }
        if (sum == G) break;
        __builtin_amdgcn_s_sleep(1);
        if ((++sp & 255u) == 0u) { if (xb_ld(&bar[XB_TMO])) break; if (sp > XB_SPIN_CAP) { atomicAdd(&bar[XB_TMO], 1u); break; } }
    }
    nloc = mine > 0u ? mine : 1u; nx = cnt > 0u ? cnt : 1u;
}
__device__ __forceinline__ void xcd_barrier(const XcdBarrier& b, bool leader) {
    asm volatile("s_waitcnt vmcnt(0)" ::: "memory");
    __syncthreads();
    if (leader) {
        unsigned* bar = b.bar;
        __builtin_amdgcn_s_waitcnt(0);
        unsigned nloc = b.st[0], nx = b.st[1];
        if (nloc == 0u) { xcd_barrier_complete(bar, b.x, nloc, nx); b.st[0] = nloc; b.st[1] = nx; }
        const unsigned old = xb_add(&bar[XB_XSUB(b.x)], 1u);
        const unsigned gen = old / nloc;
        if (old + 1u == (gen + 1u) * nloc) {
            __builtin_amdgcn_fence(__ATOMIC_RELEASE, "agent");
            asm volatile("s_waitcnt vmcnt(0)" ::: "memory");
            const unsigned og = xb_add(&bar[XB_TOP], 1u);
            const unsigned tg = og / nx;
            if (og + 1u == (tg + 1u) * nx) xb_add(&bar[XB_TOPGEN], 1u);
            else XB_SPIN(xb_ld(&bar[XB_TOPGEN]) == tg, bar);
            __builtin_amdgcn_fence(__ATOMIC_ACQUIRE, "agent");
            xb_add(&bar[XB_XGEN(b.x)], 1u);
            asm volatile("s_waitcnt vmcnt(0)" ::: "memory");
        } else {
            XB_SPIN(xb_ld(&bar[XB_XGEN(b.x)]) == gen, bar);
            __builtin_amdgcn_fence(__ATOMIC_ACQUIRE, "agent");
            asm volatile("s_waitcnt vmcnt(0)" ::: "memory");
        }
    }
    __syncthreads();
}

constexpr int MISC_OFF = 147456 - 128;
__global__ void __launch_bounds__(512, 2) fwd_kernel(Args args) {
    extern __shared__ __attribute__((aligned(16))) unsigned char lds[];
    const int wave_s = __builtin_amdgcn_readfirstlane((int)(threadIdx.x >> 6)) & 7;
    volatile LAS unsigned* MISC = (volatile LAS unsigned*)((LAS unsigned char*)lds + MISC_OFF);
    { const int l0 = lane_id_v(); if (wave_s == 0 && l0 < 32) MISC[l0] = 0u; }
    __syncthreads();
#define LEADER() (wave_s == 0 && lane_id_v() == 0)
    XcdBarrier bar = xcd_barrier_post((unsigned*)(args.ws + WS_CTL) + CW_BAR, MISC + 8, LEADER());
    const int lo = args.ph_lo, hi = args.ph_hi;
#ifndef PH_MASK
#define PH_MASK 0xffffffffu
#endif
#define IN(k) (((PH_MASK >> (k)) & 1u) && lo <= (k) && (k) < hi)
#define MKC() Ctx C; C.lane = lane_id_v(); C.wave = wave_s; C.tid = wave_s * 64 + C.lane; C.wgid = blockIdx.x; C.G = args.G; C.gw = C.wgid * 8 + C.wave; C.NGW = C.G * 8; C.lds = (LAS unsigned char*)lds; C.a = &args
#define SEAM(k) do { if (IN(k) && IN((k) + 1)) xcd_barrier(bar, LEADER()); } while (0)
    if (IN(0)) { MKC(); ph_prologue(C); } SEAM(0);
    if (IN(1)) { MKC(); ph_cumscan(C); ph_gemm1(C); } SEAM(1);
#if defined(ONLY_S5)
    if (IN(2)) { MKC(); ph_s5(C); } SEAM(2);
#elif defined(ONLY_ATT)
    if (IN(2)) { MKC(); ph_attention(C); } SEAM(2);
#else
    if (IN(2)) { MKC(); ph_attention(C); }
    if (IN(2)) { MKC(); ph_s5(C); } SEAM(2);
#endif
    if (IN(3)) { MKC(); ph_glu(C); } SEAM(3);
    if (IN(4)) { MKC(); ph_norm(C); } SEAM(4);
    if (IN(5)) { MKC(); ph_wout(C); } SEAM(5);
    if (IN(6)) { MKC(); ph_ln1(C); } SEAM(6);
    if (IN(7)) { MKC(); ph_router(C); } SEAM(7);
    if (IN(8)) { MKC(); ph_moe_up(C); } SEAM(8);
    if (IN(9)) { MKC(); ph_moe_down(C); } SEAM(9);
    if (IN(10)) { MKC(); ph_final(C); }
#undef MKC
#undef LEADER
#undef IN
#undef SEAM
}

extern "C" void kernel_launch(void* const* d_in, const int* in_sizes, int n_in, void* d_out, int out_size, void* d_ws, size_t ws_size, hipStream_t stream) {
    static int grid = 0;
    if (grid == 0) {
        if (n_in != 27 || in_sizes[0] != T * DM || out_size != T * DM || ws_size < WS_END) {
            fprintf(stderr, "kernel_launch: unexpected shapes: n_in %d in0 %d out %d ws %zu\n", n_in, n_in > 0 ? in_sizes[0] : -1, out_size, ws_size); grid = -1; return; }
        int dev = 0, cus = 0;
        if (hipGetDevice(&dev) != hipSuccess || hipDeviceGetAttribute(&cus, hipDeviceAttributeMultiprocessorCount, dev) != hipSuccess) { grid = -1; return; }
        if (hipFuncSetAttribute((const void*)fwd_kernel, hipFuncAttributeMaxDynamicSharedMemorySize, LDS_BYTES) != hipSuccess) { fprintf(stderr, "kernel_launch: hipFuncSetAttribute failed\n"); grid = -1; return; }
        grid = cus > 0 ? cus : 256;
    }
    if (grid < 0) return;
    (void)hipMemsetAsync((char*)d_ws + WS_CTL, 0, CTL_BYTES, stream);
    Args a{};
    for (int i = 0; i < 27; ++i) a.in[i] = (const float*)d_in[i];
    a.out = (float*)d_out; a.ws = (unsigned char*)d_ws;
    a.ph_lo = 0; a.ph_hi = NPHASE; a.G = grid; a.pad = 0;
    hipLaunchKernelGGL(fwd_kernel, dim3(grid), dim3(512), LDS_BYTES, stream, a);
}
```
